# Optimizing an MI355X kernel written in HIP

```python
import jax, jax.numpy as jnp
from jax import lax
import numpy as np

D_MODEL = 1024
BATCH = 1
SEQ = 16384
DEPTH = 4

GRID_W = 64
CTX_LEN = 256
N_MIXERS = 3
N_FNET_LAYERS = (DEPTH + 2) // 3
N_ATTN_LAYERS = (DEPTH + 1) // 3
N_POOL_LAYERS = DEPTH // 3
N_DENSE_LAYERS = (DEPTH + 1) // 2
N_MOE_LAYERS = DEPTH // 2

FNET_GROUPS = 4
FNET_GROUP_DIM = D_MODEL // FNET_GROUPS

N_HEADS = 16
N_KV_HEADS = 4
HEAD_DIM = D_MODEL // N_HEADS
Q_PER_KV = N_HEADS // N_KV_HEADS
Q_COLS = N_HEADS * HEAD_DIM
KV_COLS = N_KV_HEADS * HEAD_DIM
WINDOW = 128
ATTN_BLOCK = 128
ROPE_BASE = 10000.0

POOL_WINDOWS = (2, 4, 8, 16)
POOL_GROUPS = len(POOL_WINDOWS)
POOL_GROUP_DIM = D_MODEL // POOL_GROUPS

D_FF = 3584
N_EXPERTS = 8
TOP_K = 2

NORM_EPS = 1e-6
NEG_INF = -1e30

kernel_name = "hybrid_fnet_swa_pool_moe_dit"


def rms_norm(x, gain):
    xf = x.astype(jnp.float32)
    y = xf * lax.rsqrt(jnp.mean(xf * xf, axis=-1, keepdims=True) + NORM_EPS)
    return (y * gain.astype(jnp.float32)).astype(x.dtype)


def ada_params(cond, w, b):
    m = jax.nn.silu(cond) @ w + b
    return [t[..., None, :] for t in jnp.split(m, 6, axis=-1)]


def modulate(h, shift, scale):
    return h * (1 + scale) + shift


def fourier_mix(h, w):
    b, l, d = h.shape
    hg = h.astype(jnp.float32).reshape(b, l, FNET_GROUPS, FNET_GROUP_DIM)
    f = jnp.fft.fft2(hg, axes=(1, 3), norm="ortho").real
    return f.reshape(b, l, d).astype(h.dtype) @ w


def axial_rope_tables(length):
    rows = length // GRID_W
    row_pos = jnp.repeat(jnp.arange(rows, dtype=jnp.float32), GRID_W)
    col_pos = jnp.tile(jnp.arange(GRID_W, dtype=jnp.float32), rows)
    axis_dim = HEAD_DIM // 2
    inv_freq = ROPE_BASE ** (-jnp.arange(0, axis_dim, 2, dtype=jnp.float32) / axis_dim)
    ang_r = row_pos[:, None] * inv_freq[None, :]
    ang_c = col_pos[:, None] * inv_freq[None, :]
    return jnp.cos(ang_r), jnp.sin(ang_r), jnp.cos(ang_c), jnp.sin(ang_c)


def rope_part(xp, cos, sin):
    x1, x2 = jnp.split(xp, 2, axis=-1)
    cs = cos[None, :, None, :]
    sn = sin[None, :, None, :]
    return jnp.concatenate([x1 * cs - x2 * sn, x1 * sn + x2 * cs], axis=-1)


def apply_axial_rope(x, cos_r, sin_r, cos_c, sin_c):
    xf = x.astype(jnp.float32)
    half = HEAD_DIM // 2
    out = jnp.concatenate([rope_part(xf[..., :half], cos_r, sin_r),
                           rope_part(xf[..., half:], cos_c, sin_c)], axis=-1)
    return out.astype(x.dtype)


def q_heads(q_flat, gain):
    b, l, _ = q_flat.shape
    return rms_norm(q_flat.reshape(b, l, N_HEADS, HEAD_DIM), gain)


def kv_heads(kv_flat, gain):
    b, l, _ = kv_flat.shape
    k, v = jnp.split(kv_flat, 2, axis=-1)
    k = rms_norm(k.reshape(b, l, N_KV_HEADS, HEAD_DIM), gain)
    return k, v.reshape(b, l, N_KV_HEADS, HEAD_DIM)


def latent_window_attention(q, k, v, kc, vc, sink):
    b, l, _, _ = q.shape
    nb = l // ATTN_BLOCK
    scale = HEAD_DIM ** -0.5
    qb = q.astype(jnp.float32).reshape(b, nb, ATTN_BLOCK, N_KV_HEADS, Q_PER_KV, HEAD_DIM) * scale

    def band(t):
        tp = jnp.pad(t.astype(jnp.float32), ((0, 0), (ATTN_BLOCK, ATTN_BLOCK), (0, 0), (0, 0)))
        tp = tp.reshape(b, nb + 2, ATTN_BLOCK, N_KV_HEADS, HEAD_DIM)
        return jnp.concatenate([tp[:, :-2], tp[:, 1:-1], tp[:, 2:]], axis=2)

    kb = band(k)
    vb = band(v)
    blk = jnp.arange(nb)[:, None, None]
    q_pos = blk * ATTN_BLOCK + jnp.arange(ATTN_BLOCK)[None, :, None]
    k_pos = (blk - 1) * ATTN_BLOCK + jnp.arange(3 * ATTN_BLOCK)[None, None, :]
    valid = (jnp.abs(q_pos - k_pos) <= WINDOW) & (k_pos >= 0) & (k_pos < l)

    s_loc = jnp.einsum('bnqkgd,bnskd->bnkgqs', qb, kb)
    s_loc = jnp.where(valid[None, :, None, None], s_loc, NEG_INF)
    kcf = kc.astype(jnp.float32)
    vcf = vc.astype(jnp.float32)
    s_ctx = jnp.einsum('bnqkgd,bckd->bnkgqc', qb, kcf)
    sk = sink.astype(jnp.float32).reshape(N_KV_HEADS, Q_PER_KV)[None, None, :, :, None, None]
    m = jnp.maximum(jnp.maximum(s_loc.max(-1, keepdims=True), s_ctx.max(-1, keepdims=True)), sk)
    p_loc = jnp.exp(s_loc - m)
    p_ctx = jnp.exp(s_ctx - m)
    denom = p_loc.sum(-1, keepdims=True) + p_ctx.sum(-1, keepdims=True) + jnp.exp(sk - m)
    o = (jnp.einsum('bnkgqs,bnskd->bnkgqd', p_loc, vb)
         + jnp.einsum('bnkgqc,bckd->bnkgqd', p_ctx, vcf)) / denom
    o = o.transpose(0, 1, 4, 2, 3, 5).reshape(b, l, N_HEADS * HEAD_DIM)
    return o.astype(q.dtype)


def context_attention(qc, kc, vc, sink):
    b, cl, _, _ = qc.shape
    qg = qc.astype(jnp.float32).reshape(b, cl, N_KV_HEADS, Q_PER_KV, HEAD_DIM) * HEAD_DIM ** -0.5
    s = jnp.einsum('bqkgd,bckd->bkgqc', qg, kc.astype(jnp.float32))
    sk = jnp.broadcast_to(sink.astype(jnp.float32).reshape(N_KV_HEADS, Q_PER_KV)[None, :, :, None, None],
                          s.shape[:-1] + (1,))
    p = jax.nn.softmax(jnp.concatenate([s, sk], axis=-1), axis=-1)[..., :-1]
    o = jnp.einsum('bkgqc,bckd->bqkgd', p, vc.astype(jnp.float32))
    return o.reshape(b, cl, N_HEADS * HEAD_DIM).astype(qc.dtype)


def attention_mixer(h, hc, wqkv, wo, q_gain, k_gain, sink, rope, ctx_queries):
    cos_r, sin_r, cos_c, sin_c = rope
    qkv = h @ wqkv
    q = apply_axial_rope(q_heads(qkv[..., :Q_COLS], q_gain), cos_r, sin_r, cos_c, sin_c)
    k, v = kv_heads(qkv[..., Q_COLS:], k_gain)
    k = apply_axial_rope(k, cos_r, sin_r, cos_c, sin_c)
    if ctx_queries:
        qkv_c = hc @ wqkv
        kc, vc = kv_heads(qkv_c[..., Q_COLS:], k_gain)
        yc = context_attention(q_heads(qkv_c[..., :Q_COLS], q_gain), kc, vc, sink) @ wo
    else:
        kc, vc = kv_heads(hc @ wqkv[:, Q_COLS:], k_gain)
        yc = None
    y = latent_window_attention(q, k, v, kc, vc, sink) @ wo
    return y, yc


def multiscale_pool(h, w, scale):
    b, l, d = h.shape
    hg = h.astype(jnp.float32).reshape(b, l, POOL_GROUPS, POOL_GROUP_DIM)
    cs = jnp.pad(lax.cumsum(hg, axis=1), ((0, 0), (1, 0), (0, 0), (0, 0)))
    t = jnp.arange(l)[:, None]
    win = jnp.array(POOL_WINDOWS, dtype=jnp.int32)[None, :]
    lo = jnp.clip(t - win // 2, 0, l - 1)
    hi = jnp.clip(t + win - win // 2 - 1, 0, l - 1)
    g = jnp.arange(POOL_GROUPS)[None, :]
    win_sum = cs[:, hi + 1, g, :] - cs[:, lo, g, :]
    count = (hi - lo + 1).astype(jnp.float32)[None, :, :, None]
    pooled = (win_sum / count - hg).astype(h.dtype)
    y = jnp.einsum('blgc,gcd->blgd', pooled, w).reshape(b, l, d)
    return y * scale


def swiglu(h, wi, wo):
    gate, up = jnp.split(h @ wi, 2, axis=-1)
    return (jax.nn.silu(gate) * up) @ wo


def moe_swiglu(h, router, wi, wo):
    logits = (h @ router).astype(jnp.float32)
    top_val, top_idx = lax.top_k(logits, TOP_K)
    top_w = jax.nn.softmax(top_val, axis=-1)
    combine = jnp.sum(top_w[..., None] * jax.nn.one_hot(top_idx, N_EXPERTS, dtype=jnp.float32), axis=-2)
    out = jnp.zeros(h.shape, jnp.float32)
    for e in range(N_EXPERTS):
        out = out + combine[..., e:e + 1] * swiglu(h, wi[e], wo[e]).astype(jnp.float32)
    return out.astype(h.dtype)


def setup_inputs(seed: int = 0) -> dict:
    key = jax.random.key(seed)
    ks = iter(jax.random.split(key, 32))

    def nrm(shape, s):
        return jax.random.normal(next(ks), shape, jnp.float32) * s

    D = D_MODEL
    return {
        "x": nrm((BATCH, SEQ, D), 1.0),
        "c": nrm((BATCH, D), 1.0),
        "ctx": nrm((BATCH, CTX_LEN, D), 1.0),
        "c_ctx": nrm((D,), 1.0),
        "ada_w": nrm((DEPTH, D, 6 * D), 0.5 * D ** -0.5),
        "ada_b": nrm((DEPTH, 6 * D), 0.02),
        "norm_mix": 1.0 + nrm((DEPTH, D), 0.02),
        "norm_ffn": 1.0 + nrm((DEPTH, D), 0.02),
        "fnet_w": nrm((N_FNET_LAYERS, D, D), D ** -0.5),
        "attn_wqkv": nrm((N_ATTN_LAYERS, D, Q_COLS + 2 * KV_COLS), D ** -0.5),
        "attn_q_gain": 1.0 + nrm((N_ATTN_LAYERS, HEAD_DIM), 0.02),
        "attn_k_gain": 1.0 + nrm((N_ATTN_LAYERS, HEAD_DIM), 0.02),
        "attn_sink": nrm((N_ATTN_LAYERS, N_HEADS), 0.5),
        "attn_wo": nrm((N_ATTN_LAYERS, Q_COLS, D), Q_COLS ** -0.5),
        "pool_w": nrm((N_POOL_LAYERS, POOL_GROUPS, POOL_GROUP_DIM, POOL_GROUP_DIM), POOL_GROUP_DIM ** -0.5),
        "pool_scale": 1.0 + nrm((N_POOL_LAYERS, D), 0.1),
        "ffn_wi": nrm((N_DENSE_LAYERS, D, 2 * D_FF), D ** -0.5),
        "ffn_wo": nrm((N_DENSE_LAYERS, D_FF, D), D_FF ** -0.5),
        "moe_router": nrm((N_MOE_LAYERS, D, N_EXPERTS), D ** -0.5),
        "moe_wi": nrm((N_MOE_LAYERS, N_EXPERTS, D, 2 * D_FF), D ** -0.5),
        "moe_wo": nrm((N_MOE_LAYERS, N_EXPERTS, D_FF, D), D_FF ** -0.5),
    }


def reference(x, c, ctx, c_ctx, ada_w, ada_b, norm_mix, norm_ffn, fnet_w, attn_wqkv, attn_q_gain,
              attn_k_gain, attn_sink, attn_wo, pool_w, pool_scale, ffn_wi, ffn_wo, moe_router,
              moe_wi, moe_wo):
    rope = axial_rope_tables(x.shape[1])
    attn_layers = [i for i in range(DEPTH) if i % N_MIXERS == 1]
    last_ctx_read = attn_layers[-1] if attn_layers else -1

    for i in range(DEPTH):
        mixer = i % N_MIXERS
        j = i // N_MIXERS
        f = i // 2
        ctx_full = i < last_ctx_read
        ctx_live = i <= last_ctx_read

        sh1, sc1, g1, sh2, sc2, g2 = ada_params(c, ada_w[i], ada_b[i])
        h = modulate(rms_norm(x, norm_mix[i]), sh1, sc1)
        if ctx_live:
            csh1, csc1, cg1, csh2, csc2, cg2 = ada_params(c_ctx, ada_w[i], ada_b[i])
            hc = modulate(rms_norm(ctx, norm_mix[i]), csh1, csc1)

        yc = None
        if mixer == 0:
            y = fourier_mix(h, fnet_w[j])
            if ctx_full:
                yc = fourier_mix(hc, fnet_w[j])
        elif mixer == 1:
            y, yc = attention_mixer(h, hc, attn_wqkv[j], attn_wo[j], attn_q_gain[j], attn_k_gain[j],
                                    attn_sink[j], rope, ctx_full)
        else:
            y = multiscale_pool(h, pool_w[j], pool_scale[j])
            if ctx_full:
                yc = multiscale_pool(hc, pool_w[j], pool_scale[j])

        x = x + g1 * y
        h2 = modulate(rms_norm(x, norm_ffn[i]), sh2, sc2)
        if i % 2 == 0:
            x = x + g2 * swiglu(h2, ffn_wi[f], ffn_wo[f])
        else:
            x = x + g2 * moe_swiglu(h2, moe_router[f], moe_wi[f], moe_wo[f])

        if ctx_full:
            ctx = ctx + cg1 * yc
            hc2 = modulate(rms_norm(ctx, norm_ffn[i]), csh2, csc2)
            if i % 2 == 0:
                ctx = ctx + cg2 * swiglu(hc2, ffn_wi[f], ffn_wo[f])
            else:
                ctx = ctx + cg2 * moe_swiglu(hc2, moe_router[f], moe_wi[f], moe_wo[f])
    return x
```

```cpp
#include <hip/hip_runtime.h>
#include <hip/hip_cooperative_groups.h>
#include <cstdio>
namespace cg = cooperative_groups;

#ifndef DEFER
#define DEFER 1
#endif
#ifndef DEFER_HOOKS
#define DEFER_HOOKS 1
#endif
#ifndef MOE_SPLIT
#define MOE_SPLIT 1
#endif
#ifndef N_LAUNCH_MODE
#define N_LAUNCH_MODE 1
#endif

#define LAS __attribute__((address_space(3)))
typedef unsigned short bf16_t;
typedef short bf16x8 __attribute__((ext_vector_type(8)));
typedef float f32x4 __attribute__((ext_vector_type(4)));
typedef float f32x16 __attribute__((ext_vector_type(16)));
typedef unsigned u32x4 __attribute__((ext_vector_type(4)));
typedef unsigned u32x2 __attribute__((ext_vector_type(2)));
typedef float f32x2 __attribute__((ext_vector_type(2)));

constexpr int D = 1024, SEQ = 16384, CTXL = 256, MTOT = SEQ + CTXL, DFF = 3584, NEXP = 8;
constexpr int NTHR = 512, NWAVE = 8;
constexpr int KSPL = 7, KCH = DFF / KSPL;
constexpr int LDS_BYTES = 131072, LDS_ALLOC = LDS_BYTES + 16;
constexpr int MOE_ROWS = 2 * SEQ + NEXP * 256;

constexpr size_t O_CTL   = 0;
constexpr int CSTR = 64;
constexpr size_t O_ADA   = 4096;
constexpr size_t O_TW    = O_ADA + 4 * 2 * 6 * 1024 * 4;
constexpr size_t O_ROPE  = O_TW + 16384 * 8;
constexpr size_t O_FM1   = O_ROPE + 256 * 16 * 8;
constexpr size_t O_FM2   = O_FM1 + 131072;
constexpr size_t O_FC    = O_FM2 + 131072;
constexpr size_t O_ROUTE = O_FC + 262144;
constexpr size_t O_RW    = O_ROUTE + 262144;
constexpr size_t O_WFT   = O_RW + 131072;
constexpr size_t O_WQKV  = O_WFT + (size_t)2 * 2048 * 1024 * 2;
constexpr size_t O_WO    = O_WQKV + (size_t)1536 * 1024 * 2;
constexpr size_t O_POOLW = O_WO + (size_t)1024 * 1024 * 2;
constexpr size_t O_FWI   = O_POOLW + (size_t)1024 * 256 * 2;
constexpr size_t O_FWO   = O_FWI + (size_t)2 * 7168 * 1024 * 2;
constexpr size_t O_MWI   = O_FWO + (size_t)2 * 1024 * 3584 * 2;
constexpr size_t O_MWO   = O_MWI + (size_t)16 * 7168 * 1024 * 2;
constexpr size_t O_XRES  = O_MWO + (size_t)16 * 1024 * 3584 * 2;
constexpr size_t O_HBUF  = O_XRES + (size_t)MTOT * 1024 * 4;
constexpr size_t O_ZT    = O_HBUF + (size_t)MTOT * 1024 * 2;
constexpr size_t O_ZCT   = O_ZT + (size_t)131072 * 256 * 2;
constexpr size_t O_YP    = O_ZCT + (size_t)1024 * 512 * 2;
constexpr size_t O_HID   = O_YP + (size_t)131072 * 256 * 2;
constexpr size_t O_QK    = O_HID + (size_t)MTOT * 3584 * 2;
constexpr size_t O_VT    = O_QK + (size_t)MTOT * 1280 * 2;
constexpr size_t O_AO    = O_VT + (size_t)256 * MTOT * 2;
constexpr size_t O_HS    = O_AO + (size_t)SEQ * 1024 * 2;
constexpr size_t O_HIDS  = O_HS + (size_t)MOE_ROWS * 1024 * 2;
constexpr size_t O_YS    = O_HIDS + (size_t)MOE_ROWS * 3584 * 2;
constexpr size_t O_POOL  = O_YS + (size_t)MOE_ROWS * 1024 * 4;
constexpr size_t O_BAR   = O_POOL + (size_t)65536 * 256 * 2;
constexpr size_t O_FWT   = O_BAR + 32768;
constexpr size_t O_TMAT  = O_FWT + (size_t)2 * 1024 * 1024 * 2;
constexpr size_t O_ZERO  = O_BAR + 16384;
constexpr size_t O_YSP   = O_TMAT + 512 * 256 * 2;
constexpr size_t O_BLK   = O_YSP + (size_t)KSPL * 2048 * 1024 * 4;
constexpr size_t O_SROW  = O_BLK + 1024 * 8 * 4;
constexpr size_t O_INV   = O_SROW + 16384 * 8;
constexpr size_t O_PART  = O_INV + (size_t)MOE_ROWS * 4;
constexpr size_t WS_END  = O_PART + 64 * 4 * 256 * 4;

struct Params {
    const float *x, *c, *ctx, *c_ctx, *ada_w, *ada_b, *norm_mix, *norm_ffn, *fnet_w, *wqkv, *q_gain, *k_gain, *sink, *attn_wo,
        *pool_w, *pool_scale, *ffn_wi, *ffn_wo, *router, *moe_wi, *moe_wo;
    float* out; unsigned char* ws; int ph_lo, ph_hi;
};

__device__ __forceinline__ unsigned pk2(float lo, float hi) { unsigned r; asm("v_cvt_pk_bf16_f32 %0, %1, %2" : "=v"(r) : "v"(lo), "v"(hi)); return r; }
__device__ __forceinline__ int get_tid() { int t = threadIdx.x; asm volatile("" : "+v"(t)); return t; }
__device__ __forceinline__ int get_bid() { int b = blockIdx.x; asm volatile("" : "+s"(b)); return b; }
__device__ __forceinline__ float bf2f(bf16_t b) { return __uint_as_float(((unsigned)b) << 16); }
__device__ __forceinline__ float bflo(unsigned u) { return __uint_as_float(u << 16); }
__device__ __forceinline__ float bfhi(unsigned u) { return __uint_as_float(u & 0xFFFF0000u); }
__device__ __forceinline__ float wave_sum(float v) {
#pragma unroll
    for (int o = 1; o < 64; o <<= 1) v += __shfl_xor(v, o);
    return v;
}
__device__ __forceinline__ int xcd_remap(int L, int nwg) { const int q = nwg >> 3, r = nwg & 7, xcd = L & 7, off = L >> 3; return (xcd < r ? xcd * (q + 1) : r * (q + 1) + (xcd - r) * q) + off; }
__device__ __forceinline__ float silu_f(float v) { return v * __builtin_amdgcn_rcpf(1.f + __expf(-v)); }


#define XB_TMO      128
#define XB_XCNT(j)  (256  + 64 * (j))
#define XB_XSUB(j)  (1280 + 64 * (j))
#define XB_XGEN(j)  (2304 + 64 * (j))
#define XB_TOP      3328
#define XB_TOPGEN   3392
#define XCD_BAR_WORDS 3456
#define XB_SPIN_CAP (1u << 18)
__device__ __forceinline__ unsigned xb_ld(unsigned* p)              { return __hip_atomic_load(p, __ATOMIC_RELAXED, __HIP_MEMORY_SCOPE_AGENT); }
__device__ __forceinline__ unsigned xb_add(unsigned* p, unsigned v) { return __hip_atomic_fetch_add(p, v, __ATOMIC_RELAXED, __HIP_MEMORY_SCOPE_AGENT); }
__device__ __forceinline__ unsigned xb_xcc_id() { return (unsigned)__builtin_amdgcn_s_getreg((3 << 11) | 20) & 0xFu; }
#define XB_SPIN(cond, bar) do { unsigned _sp = 0; while (cond) { __builtin_amdgcn_s_sleep(1); \
    if ((++_sp & 255u) == 0u) { if (xb_ld(&(bar)[XB_TMO])) break; if (_sp > XB_SPIN_CAP) { atomicAdd(&(bar)[XB_TMO], 1u); break; } } } } while (0)
struct XcdBarrier { unsigned* bar; unsigned x; volatile LAS unsigned* st; };
__device__ __forceinline__ XcdBarrier xcd_barrier_post(unsigned* bar, volatile LAS unsigned* st) {
    XcdBarrier b; b.bar = bar; b.x = xb_xcc_id(); b.st = st;
    if (threadIdx.x == 0) (void)xb_add(&bar[XB_XCNT(b.x)], 1u);
    return b;
}
__device__ __forceinline__ void xcd_barrier_complete(unsigned* bar, unsigned x, unsigned& nloc, unsigned& nx) {
    const unsigned G = gridDim.x * gridDim.y * gridDim.z;
    unsigned sum, cnt, mine, sp = 0u;
    for (;;) {
        sum = 0u; cnt = 0u; mine = 0u;
#pragma unroll
        for (unsigned j = 0; j < 16; ++j) { const unsigned c = xb_ld(&bar[XB_XCNT(j)]); sum += c; cnt += (c > 0u) ? 1u : 0u; mine = (j == x) ? c : mine; }
        if (sum == G) break;
        __builtin_amdgcn_s_sleep(1);
        if ((++sp & 255u) == 0u) { if (xb_ld(&bar[XB_TMO])) break; if (sp > XB_SPIN_CAP) { atomicAdd(&bar[XB_TMO], 1u); break; } }
    }
    nloc = mine > 0u ? mine : 1u; nx = cnt > 0u ? cnt : 1u;
}
__device__ __forceinline__ void xcd_barrier(const XcdBarrier& b) {
    asm volatile("s_waitcnt vmcnt(0)" ::: "memory");
    __syncthreads();
    if (threadIdx.x == 0) {
        unsigned* bar = b.bar;
        __builtin_amdgcn_s_waitcnt(0);
        unsigned nloc = b.st[0], nx = b.st[1];
        if (nloc == 0u) { xcd_barrier_complete(bar, b.x, nloc, nx); b.st[0] = nloc; b.st[1] = nx; }
        const unsigned old = xb_add(&bar[XB_XSUB(b.x)], 1u);
        const unsigned gen = old / nloc;
        if (old + 1u == (gen + 1u) * nloc) {
            __builtin_amdgcn_fence(__ATOMIC_RELEASE, "agent");
            asm volatile("s_waitcnt vmcnt(0)" ::: "memory");
            const unsigned og = xb_add(&bar[XB_TOP], 1u);
            const unsigned tg = og / nx;
            if (og + 1u == (tg + 1u) * nx) xb_add(&bar[XB_TOPGEN], 1u);
            else XB_SPIN(xb_ld(&bar[XB_TOPGEN]) == tg, bar);
            __builtin_amdgcn_fence(__ATOMIC_ACQUIRE, "agent");
            xb_add(&bar[XB_XGEN(b.x)], 1u);
            asm volatile("s_waitcnt vmcnt(0)" ::: "memory");
        } else {
            XB_SPIN(xb_ld(&bar[XB_XGEN(b.x)]) == gen, bar);
            __builtin_amdgcn_fence(__ATOMIC_ACQUIRE, "agent");
            asm volatile("s_waitcnt vmcnt(0)" ::: "memory");
        }
    }
    __syncthreads();
}

constexpr int BM = 256, BK = 64, HALF = 128, HTB = HALF * BK * 2, WGM = 8;
__device__ __forceinline__ int lds_byte(int r, int c) { const int st = (r >> 4) * 2 + (c >> 5), rr = r & 15, cc = c & 31, ob = rr * 64 + cc * 2; return st * 1024 + (ob ^ (((ob >> 9) & 1) << 5)); }
__device__ __forceinline__ void stage_rc(int b, int& R, int& C) { const int st = b / 1024, sb = b % 1024, swz = sb ^ (((sb >> 9) & 1) << 5); R = (st >> 1) * 16 + swz / 64; C = (st & 1) * 32 + (swz % 64) / 2; }
__device__ __forceinline__ int perm32(int rho) { const int n = rho >> 4, i = rho & 15; return 8 * (i >> 2) + 4 * n + (i & 3); }

struct Unit { int pm, pn; const char* a; const char* b; };

struct SchedGrid {   static constexpr bool GATHER = false;
    int nM, nN, nwg, boff = 0; const char* A; const char* B; size_t tstep;
    __device__ __forceinline__ void init(const void* A_, const void* B_, int M, int N, int K) { nM = M / BM; nN = N / BM; nwg = nM * nN; A = (const char*)A_; B = (const char*)B_; tstep = (size_t)BM * K * 2; }
    __device__ __forceinline__ bool next(int i, Unit& u) const {
        const int G = (int)gridDim.x; int vb = get_bid() + boff; vb = vb >= G ? vb - G : vb;
        const int L = i * G + vb; if (L >= nwg) return false;
        const int wgid = xcd_remap(L, nwg);
        const int nig = WGM * nN, gid = wgid / nig, fm = gid * WGM, gsz = (nM - fm) < WGM ? (nM - fm) : WGM;
        u.pm = fm + ((wgid % nig) % gsz); u.pn = (wgid % nig) / gsz;
        u.a = A + (size_t)u.pm * tstep; u.b = B + (size_t)u.pn * tstep; return true;
    }
};
struct SchedPool {   static constexpr bool GATHER = false;
    const char* A; const char* B; size_t tstep;
    __device__ __forceinline__ bool next(int i, Unit& u) const {
        const int L = i * (int)gridDim.x + get_bid(); if (L >= 256) return false;
        const int wgid = xcd_remap(L, 256);
        u.pm = wgid; u.pn = wgid >> 6; u.a = A + (size_t)u.pm * tstep; u.b = B + (size_t)u.pn * tstep; return true;
    }
};
struct SchedFold {   static constexpr bool GATHER = false;
    const char* A; const char* B;
    __device__ __forceinline__ bool next(int i, Unit& u) const {
        const int L = i * (int)gridDim.x + get_bid(); if (L >= 64) return false;
        const int c = L & 1, pm = (L >> 1) & 3, g = (L >> 3) & 3, j = L >> 5;
        u.pm = ((j * 4 + g) << 2) + pm; u.pn = c;
        u.a = A + ((size_t)j * 1024 * 1024 + (size_t)pm * 256 * 1024 + g * 256) * 2; u.b = B + (size_t)c * 256 * 256 * 2; return true;
    }
};
struct SchedSplit {   static constexpr bool GATHER = false;
    const int* cnt; int tile0, ntile, moe; const char* A; const char* B; size_t estride;
    __device__ __forceinline__ bool next(int i, Unit& u) const {
        const int L = i * (int)gridDim.x + get_bid(); if (L >= ntile * 4 * KSPL) return false;
        const int t = L / (4 * KSPL), rem = L % (4 * KSPL), ks = rem >> 2, pn = rem & 3, pm = tile0 + t;
        int es = 0;
        if (moe) { int a2 = 0;
#pragma unroll
            for (int e = 0; e < NEXP; ++e) { const int tt = (cnt[e * CSTR] + 255) >> 8; if (pm >= a2 && pm < a2 + tt) es = e; a2 += tt; } }
        u.pm = t; u.pn = pn * KSPL + ks;
        u.a = A + ((size_t)pm * 256 * DFF + ks * KCH) * 2; u.b = B + (size_t)es * estride + ((size_t)pn * 256 * DFF + ks * KCH) * 2; return true;
    }
};
template <bool GATHER_> struct SchedMoeT {    static constexpr bool GATHER = GATHER_; const int* inv = nullptr; const char* abase = nullptr;
    const int* cnt; int nN, T, rowmajor; const char* A; const char* B; size_t tstep, estride; int tl[NEXP];
    __device__ __forceinline__ void init(const int* cnt_, const void* A_, const void* B_, int N, int K, int rowmajor_, int maxT) {
        rowmajor = rowmajor_;
        cnt = cnt_; nN = N / BM; A = (const char*)A_; B = (const char*)B_; tstep = (size_t)BM * K * 2; estride = (size_t)N * K * 2;
        int t = 0;
#pragma unroll
        for (int e = 0; e < NEXP; ++e) { tl[e] = __builtin_amdgcn_readfirstlane((cnt[e * CSTR] + 255) >> 8); t += tl[e]; }
        T = t < maxT ? t : maxT;
    }
    __device__ __forceinline__ bool next(int i, Unit& u) const {
        const int nwg = T * nN; const int L = i * (int)gridDim.x + get_bid(); if (L >= nwg) return false;
        const int wgid = xcd_remap(L, nwg);
        int acc = 0, es = 0, ts = 0, te = 1;
#pragma unroll
        for (int e = 0; e < NEXP; ++e) { const int t = tl[e]; if (wgid >= acc * nN && wgid < (acc + t) * nN) { es = e; ts = acc; te = t; } acc += t; }
        const int r = wgid - ts * nN; u.pm = ts + r % te; u.pn = r / te;
        if (rowmajor) { u.pm = wgid / nN; u.pn = wgid % nN; int a2 = 0;
#pragma unroll
            for (int e = 0; e < NEXP; ++e) { const int t = tl[e]; if (u.pm >= a2 && u.pm < a2 + t) es = e; a2 += t; } }
        u.a = A + (size_t)u.pm * tstep; u.b = B + (size_t)es * estride + (size_t)u.pn * tstep; return true;
    }
};

template <class Epi, class Sched>
__device__ __forceinline__ void gemm_phase(LAS unsigned char* lds, const int K, const int lda, const int ldb, const Sched& S, const Epi& E) {
    const int tid = get_tid(), wid = __builtin_amdgcn_readfirstlane(tid >> 6), lane = tid & 63, wr = wid >> 2, wc = wid & 3, fr = lane & 15, fq = lane >> 4;
    const int nt = K / BK;
    constexpr bool GATHER = Sched::GATHER;
    unsigned voffA[2], voffB[2];
#pragma unroll
    for (int i = 0; i < 2; ++i) { int R, C; stage_rc(tid * 16 + i * 8192, R, C); const int Rb = Epi::PERM ? ((R & ~31) + perm32(R & 31)) : R;
        voffA[i] = (unsigned)(R * lda + C) * 2u; voffB[i] = (unsigned)(Rb * ldb + C) * 2u; }
    unsigned vcur[2][2] = {{0u, 0u}, {0u, 0u}}, vnxt[2][2] = {{0u, 0u}, {0u, 0u}}; int ix1[2][2] = {{0, 0}, {0, 0}};
    const int* invp = nullptr; if constexpr (GATHER) invp = S.inv;
    auto ld_ix = [&](int pm, int (&ix)[2][2]) {
#pragma unroll
        for (int i = 0; i < 2; ++i) { int R, C; stage_rc(get_tid() * 16 + i * 8192, R, C);
#pragma unroll
            for (int h = 0; h < 2; ++h) ix[h][i] = invp[pm * BM + h * HALF + R]; } };
    auto mk_off = [&](const int (&ix)[2][2], unsigned (&vo)[2][2]) {
#pragma unroll
        for (int i = 0; i < 2; ++i) { int R, C; stage_rc(get_tid() * 16 + i * 8192, R, C);
#pragma unroll
            for (int h = 0; h < 2; ++h) vo[h][i] = (unsigned)ix[h][i] * (unsigned)(lda * 2) + (unsigned)C * 2u; } };
    const size_t kstep = (size_t)(BK * 2);
    const size_t hstepA = (size_t)HALF * lda * 2, hstepB = (size_t)HALF * ldb * 2;
    const unsigned ldsw = (unsigned)wid * 1024u;
    const int aoff = lds_byte(wr * 64 + fr, fq * 8), boff = lds_byte(wc * 32 + fr, fq * 8);
#define PG8_SA(b, h) (((b) * 2 + (h)) * HTB)
#define PG8_SB(b, h) ((4 + (b) * 2 + (h)) * HTB)
#define PG8_STAGE(bufoff, gbase, voff) do { _Pragma("unroll") for (int _i = 0; _i < 2; ++_i) \
        __builtin_amdgcn_global_load_lds((const unsigned*)((const char*)(gbase) + (voff)[_i]), (LAS unsigned*)(lds + (bufoff) + ldsw + _i * 8192), 16, 0, 0); } while (0)
#define PG8_STAGE_A(bufoff, gbase, h, vv) do { if constexpr (GATHER) { _Pragma("unroll") for (int _i = 0; _i < 2; ++_i) \
        __builtin_amdgcn_global_load_lds((const unsigned*)((const char*)(gbase) + (vv)[h][_i]), (LAS unsigned*)(lds + (bufoff) + ldsw + _i * 8192), 16, 0, 0); } \
        else { PG8_STAGE(bufoff, (gbase) + (h) * hstepA, voffA); } } while (0)
#define PG8_LDA(dst, b, h) do { _Pragma("unroll") for (int m = 0; m < 4; ++m) _Pragma("unroll") for (int k = 0; k < 2; ++k) dst[m][k] = *(const LAS bf16x8*)(lds + PG8_SA(b, h) + aoff + m * 2048 + k * 1024); } while (0)
#define PG8_LDB(dst, b, h) do { _Pragma("unroll") for (int n = 0; n < 2; ++n) _Pragma("unroll") for (int k = 0; k < 2; ++k) dst[n][k] = *(const LAS bf16x8*)(lds + PG8_SB(b, h) + boff + n * 2048 + k * 1024); } while (0)
#define PG8_MMA(ai, bj, At, Bt) do { __builtin_amdgcn_s_setprio(1); _Pragma("unroll") for (int m = 0; m < 4; ++m) _Pragma("unroll") for (int n = 0; n < 2; ++n) _Pragma("unroll") for (int k = 0; k < 2; ++k) \
        acc[ai][bj][m][n] = __builtin_amdgcn_mfma_f32_16x16x32_bf16(Bt[n][k], At[m][k], acc[ai][bj][m][n], 0, 0, 0); __builtin_amdgcn_s_setprio(0); } while (0)
#define PG8_WAIT_V(n) asm volatile("s_waitcnt vmcnt(" #n ")" ::: "memory")
#define PG8_WAIT_L(n) asm volatile("s_waitcnt lgkmcnt(" #n ")" ::: "memory")
#define PG8_BAR __builtin_amdgcn_s_barrier()
#define PG8_SCHED __builtin_amdgcn_sched_barrier(0)
    Unit cur, nxt; int ui = 0;
    if (!S.next(0, cur)) return;
    f32x4 acc[2][2][4][2];
#pragma unroll
    for (int a = 0; a < 2; ++a)
#pragma unroll
        for (int b = 0; b < 2; ++b)
#pragma unroll
            for (int m = 0; m < 4; ++m)
#pragma unroll
                for (int n = 0; n < 2; ++n) acc[a][b][m][n] = (f32x4){0.f, 0.f, 0.f, 0.f};
    bf16x8 At[4][2], B0[2][2], B1[2][2];
    const char* cA = cur.a; const char* cB = cur.b;
    bool has_n1 = false;
    if constexpr (GATHER) {
        cA = S.abase;
        { int ix0[2][2]; ld_ix(cur.pm, ix0); mk_off(ix0, vcur); }
        has_n1 = S.next(1, nxt);
        if (has_n1) ld_ix(nxt.pm, ix1);
        asm volatile("s_waitcnt vmcnt(0)" ::: "memory");
    }
    PG8_STAGE(PG8_SB(0, 0), cB, voffB); PG8_STAGE_A(PG8_SA(0, 0), cA, 0, vcur); PG8_STAGE(PG8_SB(0, 1), cB + hstepB, voffB); PG8_STAGE_A(PG8_SA(0, 1), cA, 1, vcur);
    if (wr == 1) PG8_BAR;
    PG8_WAIT_V(4); PG8_BAR;
    PG8_STAGE(PG8_SB(1, 0), cB + kstep, voffB); PG8_STAGE_A(PG8_SA(1, 0), cA + kstep, 0, vcur); PG8_STAGE(PG8_SB(1, 1), cB + hstepB + kstep, voffB);
    PG8_WAIT_V(6); PG8_BAR;
    for (;;) {
        const bool has_next = S.next(ui + 1, nxt);
        const char* nA = has_next ? nxt.a : cA; const char* nB = has_next ? nxt.b : cB;
        if constexpr (GATHER) {
            nA = cA;
            if (has_next) mk_off(ix1, vnxt);
            else {
#pragma unroll
                for (int h = 0; h < 2; ++h)
#pragma unroll
                    for (int i = 0; i < 2; ++i) vnxt[h][i] = vcur[h][i];
            }
        }
#pragma unroll 1
        for (int t = 0; t < nt; t += 2) {
            const bool last = (t == nt - 2);
            const char* a1 = cA + (size_t)(t + 1) * kstep;
            const char* a2 = last ? nA : cA + (size_t)(t + 2) * kstep; const char* b2 = last ? nB : cB + (size_t)(t + 2) * kstep;
            const char* a3 = a2 + kstep; const char* b3 = b2 + kstep;
            PG8_LDB(B0, 0, 0); PG8_SCHED; PG8_LDA(At, 0, 0); PG8_STAGE_A(PG8_SA(1, 1), a1, 1, vcur);
            if constexpr (GATHER) { if (last) {
#pragma unroll
                for (int h = 0; h < 2; ++h)
#pragma unroll
                    for (int i = 0; i < 2; ++i) vcur[h][i] = vnxt[h][i]; } }
            PG8_WAIT_L(8); PG8_BAR; PG8_WAIT_L(0); PG8_MMA(0, 0, At, B0); PG8_BAR; PG8_SCHED;
            PG8_LDB(B1, 0, 1); PG8_STAGE(PG8_SB(0, 0), b2, voffB);
            PG8_BAR; PG8_WAIT_L(0); PG8_MMA(0, 1, At, B1); PG8_BAR;
            PG8_LDA(At, 0, 1); PG8_STAGE_A(PG8_SA(0, 0), a2, 0, vcur);
            PG8_BAR; PG8_WAIT_L(0); PG8_MMA(1, 0, At, B0); PG8_BAR; PG8_SCHED;
            PG8_STAGE(PG8_SB(0, 1), b2 + hstepB, voffB);
            PG8_WAIT_V(6); PG8_BAR; PG8_MMA(1, 1, At, B1); PG8_BAR;
            PG8_LDB(B0, 1, 0); PG8_SCHED; PG8_LDA(At, 1, 0); PG8_STAGE_A(PG8_SA(0, 1), a2, 1, vcur);
            PG8_WAIT_L(8); PG8_BAR; PG8_WAIT_L(0); PG8_MMA(0, 0, At, B0); PG8_BAR; PG8_SCHED;
            PG8_LDB(B1, 1, 1); PG8_STAGE(PG8_SB(1, 0), b3, voffB);
            PG8_BAR; PG8_WAIT_L(0); PG8_MMA(0, 1, At, B1); PG8_BAR;
            PG8_LDA(At, 1, 1); PG8_STAGE_A(PG8_SA(1, 0), a3, 0, vcur);
            PG8_BAR; PG8_WAIT_L(0); PG8_MMA(1, 0, At, B0); PG8_BAR; PG8_SCHED;
            PG8_STAGE(PG8_SB(1, 1), b3 + hstepB, voffB);
            PG8_WAIT_V(6); PG8_BAR; PG8_MMA(1, 1, At, B1); PG8_BAR;
        }
        if constexpr (GATHER) { Unit n2; if (has_next && S.next(ui + 2, n2)) ld_ix(n2.pm, ix1); }
        if constexpr (!Epi::AFTER_DRAIN) E(acc, cur, wr, wc, fr, fq);
        if (!has_next) break;
#pragma unroll
        for (int a = 0; a < 2; ++a)
#pragma unroll
            for (int b = 0; b < 2; ++b)
#pragma unroll
                for (int m = 0; m < 4; ++m)
#pragma unroll
                    for (int n = 0; n < 2; ++n) acc[a][b][m][n] = (f32x4){0.f, 0.f, 0.f, 0.f};
        cur = nxt; cA = nA; cB = nB; ++ui;

    }
    PG8_WAIT_V(0);
    if (wr == 0) PG8_BAR;
    PG8_BAR;
    if constexpr (Epi::AFTER_DRAIN) E.fused(acc, cur, wr, wc, fr, fq, lds);
#undef PG8_SA
#undef PG8_SB
#undef PG8_STAGE
#undef PG8_STAGE_A
#undef PG8_LDA
#undef PG8_LDB
#undef PG8_MMA
#undef PG8_WAIT_V
#undef PG8_WAIT_L
#undef PG8_BAR
#undef PG8_SCHED
}

typedef f32x4 Acc[2][2][4][2];

struct EpiStoreBf16 {
    static constexpr bool PERM = true, AFTER_DRAIN = false; bf16_t* O; size_t ld;
    __device__ __forceinline__ void operator()(const Acc& acc, const Unit& u, int wr, int wc, int fr, int fq) const {
        const int row0 = u.pm * BM + wr * 64 + fr, col0 = u.pn * BM + wc * 32 + 8 * fq;
#pragma unroll
        for (int ai = 0; ai < 2; ++ai)
#pragma unroll
            for (int m = 0; m < 4; ++m) { bf16_t* rp = O + (size_t)(row0 + ai * HALF + m * 16) * ld + col0;
#pragma unroll
                for (int bj = 0; bj < 2; ++bj) { const f32x4 v0 = acc[ai][bj][m][0], v1 = acc[ai][bj][m][1];
                    u32x4 o; o.x = pk2(v0[0], v0[1]); o.y = pk2(v0[2], v0[3]); o.z = pk2(v1[0], v1[1]); o.w = pk2(v1[2], v1[3]);
                    *(u32x4*)(rp + bj * HALF) = o; } }
    }
};
struct EpiFold {
    static constexpr bool PERM = true, AFTER_DRAIN = false; bf16_t* W;
    __device__ __forceinline__ void operator()(const Acc& acc, const Unit& u, int wr, int wc, int fr, int fq) const {
        const int pm = u.pm & 3, jg = u.pm >> 2, j = jg >> 2, g = jg & 3;
        const int row0 = pm * BM + wr * 64 + fr, col0 = wc * 32 + 8 * fq;
        bf16_t* base = W + ((size_t)j * 2048 + (size_t)u.pn * 1024) * 1024 + g * 256;
#pragma unroll
        for (int ai = 0; ai < 2; ++ai)
#pragma unroll
            for (int m = 0; m < 4; ++m) { bf16_t* rp = base + (size_t)(row0 + ai * HALF + m * 16) * 1024 + col0;
#pragma unroll
                for (int bj = 0; bj < 2; ++bj) { const f32x4 v0 = acc[ai][bj][m][0], v1 = acc[ai][bj][m][1];
                    u32x4 o; o.x = pk2(v0[0], v0[1]); o.y = pk2(v0[2], v0[3]); o.z = pk2(v1[0], v1[1]); o.w = pk2(v1[2], v1[3]);
                    *(u32x4*)(rp + bj * HALF) = o; } }
    }
};
struct EpiPartial {
    static constexpr bool PERM = false, AFTER_DRAIN = false; float* Yp;
    __device__ __forceinline__ void operator()(const Acc& acc, const Unit& u, int wr, int wc, int fr, int fq) const {
        const int ks = u.pn % KSPL, pn = u.pn / KSPL;
        const int row0 = u.pm * BM + wr * 64 + fr, col0 = pn * BM + wc * 32 + 4 * fq;
        float* base = Yp + (size_t)ks * 2048 * D;
#pragma unroll
        for (int ai = 0; ai < 2; ++ai)
#pragma unroll
            for (int m = 0; m < 4; ++m) { float* rp = base + (size_t)(row0 + ai * HALF + m * 16) * D + col0;
#pragma unroll
                for (int bj = 0; bj < 2; ++bj)
#pragma unroll
                    for (int n = 0; n < 2; ++n) *(f32x4*)(rp + bj * HALF + n * 16) = acc[ai][bj][m][n]; }
    }
};
struct EpiStoreF32 {
    static constexpr bool PERM = false, AFTER_DRAIN = false; float* C; size_t ld;
    __device__ __forceinline__ void operator()(const Acc& acc, const Unit& u, int wr, int wc, int fr, int fq) const {
        const int row0 = u.pm * BM + wr * 64 + fr, col0 = u.pn * BM + wc * 32 + 4 * fq;
#pragma unroll
        for (int ai = 0; ai < 2; ++ai)
#pragma unroll
            for (int m = 0; m < 4; ++m) { float* rp = C + (size_t)(row0 + ai * HALF + m * 16) * ld + col0;
#pragma unroll
                for (int bj = 0; bj < 2; ++bj)
#pragma unroll
                    for (int n = 0; n < 2; ++n) *(f32x4*)(rp + bj * HALF + n * 16) = acc[ai][bj][m][n]; }
    }
};
struct EpiResid {
    static constexpr bool PERM = false, AFTER_DRAIN = false; float* X; const float* gate_x; const float* gate_c;
    __device__ __forceinline__ void operator()(const Acc& acc, const Unit& u, int wr, int wc, int fr, int fq) const {
        const int row0 = u.pm * BM + wr * 64 + fr, col0 = u.pn * BM + wc * 32 + 4 * fq;
        const float* gp = (u.pm < SEQ / BM) ? gate_x : gate_c;
        f32x4 gv[2][2];
#pragma unroll
        for (int bj = 0; bj < 2; ++bj)
#pragma unroll
            for (int n = 0; n < 2; ++n) gv[bj][n] = *(const f32x4*)(gp + col0 + bj * HALF + n * 16);
#pragma unroll
        for (int ai = 0; ai < 2; ++ai)
#pragma unroll
            for (int m = 0; m < 4; ++m) { float* rp = X + (size_t)(row0 + ai * HALF + m * 16) * D + col0;
#pragma unroll
                for (int bj = 0; bj < 2; ++bj)
#pragma unroll
                    for (int n = 0; n < 2; ++n) { f32x4* p = (f32x4*)(rp + bj * HALF + n * 16); *p = *p + gv[bj][n] * acc[ai][bj][m][n]; } }
    }
};
template <bool POOL> struct EpiResidNorm {
    static constexpr bool PERM = false, AFTER_DRAIN = true;
    float* X; const float* gate; const float* scale; const float* gain; const float* adap  ; bf16_t* H; float* part; unsigned* cnt; int permute;
    __device__ __forceinline__ void operator()(const Acc&, const Unit&, int, int, int, int) const {}
    __device__ __forceinline__ void fused(Acc& acc, const Unit& u, int wr, int wc, int fr, int fq, LAS unsigned char* lds) const {
        const int tid = get_tid();
        const int owner = POOL ? u.pn : u.pn, panel = POOL ? (u.pm - 64 * u.pn) : u.pm;
        const int row0 = panel * BM + wr * 64 + fr, col0 = u.pn * BM + wc * 32 + 4 * fq;
        LAS float* psum = (LAS float*)lds; LAS float* rs = (LAS float*)(lds + 4096);
#pragma unroll
        for (int bj = 0; bj < 2; ++bj)
#pragma unroll
            for (int n = 0; n < 2; ++n) { const int col = col0 + bj * HALF + n * 16;
                f32x4 gv = *(const f32x4*)(gate + col); if (POOL) gv = gv * *(const f32x4*)(scale + col);
#pragma unroll
                for (int ai = 0; ai < 2; ++ai)
#pragma unroll
                    for (int m = 0; m < 4; ++m) { f32x4* p = (f32x4*)(X + (size_t)(row0 + ai * HALF + m * 16) * D + col); const f32x4 xv = *p + gv * acc[ai][bj][m][n]; *p = xv; acc[ai][bj][m][n] = xv; }
                __builtin_amdgcn_sched_barrier(0); }
#pragma unroll
        for (int ai = 0; ai < 2; ++ai)
#pragma unroll
            for (int m = 0; m < 4; ++m) { float sq = 0.f;
#pragma unroll
                for (int bj = 0; bj < 2; ++bj)
#pragma unroll
                    for (int n = 0; n < 2; ++n) { const f32x4 v = acc[ai][bj][m][n]; sq += (v[0] * v[0] + v[1] * v[1]) + (v[2] * v[2] + v[3] * v[3]); }
                sq += __shfl_xor(sq, 16); sq += __shfl_xor(sq, 32);
                if (fq == 0) psum[wc * 256 + ai * HALF + wr * 64 + m * 16 + fr] = sq; }
        __syncthreads();
        if (tid < 256) __hip_atomic_store(part + (size_t)(panel * 4 + owner) * 256 + tid, (psum[tid] + psum[256 + tid]) + (psum[512 + tid] + psum[768 + tid]), __ATOMIC_RELAXED, __HIP_MEMORY_SCOPE_AGENT);
        asm volatile("s_waitcnt vmcnt(0)" ::: "memory");
        __syncthreads();
        if (tid == 0) { unsigned* c = cnt + panel * 16; __hip_atomic_fetch_add(c, 1u, __ATOMIC_RELAXED, __HIP_MEMORY_SCOPE_AGENT);
            unsigned sp = 0; while (__hip_atomic_load(c, __ATOMIC_RELAXED, __HIP_MEMORY_SCOPE_AGENT) < 4u) { __builtin_amdgcn_s_sleep(1); if (++sp > (1u << 22)) break; } }
        __syncthreads();
        if (tid < 256) { float* pp = part + (size_t)panel * 4 * 256 + tid;
            const float p0 = __hip_atomic_load(pp, __ATOMIC_RELAXED, __HIP_MEMORY_SCOPE_AGENT), p1 = __hip_atomic_load(pp + 256, __ATOMIC_RELAXED, __HIP_MEMORY_SCOPE_AGENT),
                        p2 = __hip_atomic_load(pp + 512, __ATOMIC_RELAXED, __HIP_MEMORY_SCOPE_AGENT), p3 = __hip_atomic_load(pp + 768, __ATOMIC_RELAXED, __HIP_MEMORY_SCOPE_AGENT);
            rs[tid] = rsqrtf(((p0 + p1) + (p2 + p3)) * (1.f / D) + 1e-6f); }
        __syncthreads();
#pragma unroll
        for (int bj = 0; bj < 2; ++bj)
#pragma unroll
            for (int n = 0; n < 2; ++n) { const int col = col0 + bj * HALF + n * 16;
                const f32x4 ga = *(const f32x4*)(gain + col) * (1.f + *(const f32x4*)(adap + 1024 + col)), sh = *(const f32x4*)(adap + col);
#pragma unroll
                for (int ai = 0; ai < 2; ++ai)
#pragma unroll
                    for (int m = 0; m < 4; ++m) { const int rt = ai * HALF + wr * 64 + m * 16 + fr, row = panel * BM + rt; const float r = rs[rt];
                        const f32x4 hv = acc[ai][bj][m][n] * r * ga + sh;
                        const int orow = permute ? (128 * (row & 127) + (row >> 7)) : row;
                        u32x2 o; o.x = pk2(hv[0], hv[1]); o.y = pk2(hv[2], hv[3]); *(u32x2*)(H + (size_t)orow * D + col) = o; }
                __builtin_amdgcn_sched_barrier(0); }
        __syncthreads();
    }
};
struct EpiSwiglu {
    static constexpr bool PERM = true, AFTER_DRAIN = false; bf16_t* Hd;
    __device__ __forceinline__ void operator()(const Acc& acc, const Unit& u, int wr, int wc, int fr, int fq) const {
        const int row0 = u.pm * BM + wr * 64 + fr, col0 = u.pn * HALF + wc * 32 + 8 * fq;
#pragma unroll
        for (int ai = 0; ai < 2; ++ai)
#pragma unroll
            for (int m = 0; m < 4; ++m) { bf16_t* rp = Hd + (size_t)(row0 + ai * HALF + m * 16) * DFF + col0;
                float h[8];
#pragma unroll
                for (int n = 0; n < 2; ++n)
#pragma unroll
                    for (int e = 0; e < 4; ++e) { const float g = acc[ai][0][m][n][e], up = acc[ai][1][m][n][e]; h[4 * n + e] = silu_f(g) * up; }
                u32x4 o; o.x = pk2(h[0], h[1]); o.y = pk2(h[2], h[3]); o.z = pk2(h[4], h[5]); o.w = pk2(h[6], h[7]);
                *(u32x4*)rp = o; }
    }
};
struct EpiFZ {
    static constexpr bool PERM = true, AFTER_DRAIN = false; bf16_t* Zt; bf16_t* ZcT;
    __device__ __forceinline__ void operator()(const Acc& acc, const Unit& u, int wr, int wc, int fr, int fq) const {
        const int row0 = u.pm * BM + wr * 64 + fr, col0 = u.pn * BM + wc * 32 + 8 * fq;
#pragma unroll
        for (int ai = 0; ai < 2; ++ai)
#pragma unroll
            for (int m = 0; m < 4; ++m) { const int np = row0 + ai * HALF + m * 16, c = np >> 10, n = np & 1023;
#pragma unroll
                for (int bj = 0; bj < 2; ++bj) { const int j = col0 + bj * HALF; const f32x4 v0 = acc[ai][bj][m][0], v1 = acc[ai][bj][m][1];
                    u32x4 o; o.x = pk2(v0[0], v0[1]); o.y = pk2(v0[2], v0[3]); o.z = pk2(v1[0], v1[1]); o.w = pk2(v1[2], v1[3]);
                    bf16_t* dst;
                    if (u.pn < SEQ / BM) { const int l1 = j >> 7, l2 = j & 127; dst = Zt + ((size_t)(n * 128 + l1) * 2 + c) * 128 + l2; }
                    else { const int l = j - SEQ; dst = ZcT + (size_t)(n * 2 + c) * 256 + l; }
                    *(u32x4*)dst = o; } }
    }
};
struct EpiStep1 {
    static constexpr bool PERM = true, AFTER_DRAIN = false; bf16_t* Yp; const float2* tw;
    __device__ __forceinline__ void operator()(const Acc& acc, const Unit& u, int wr, int wc, int fr, int fq) const {
        const int col0 = u.pn * BM + wc * 32 + 8 * fq;
#pragma unroll
        for (int m = 0; m < 4; ++m) { const int ka = wr * 64 + m * 16 + fr; const float2 st = tw[ka]; const float2 t0 = tw[ka * (col0 & 127)];
#pragma unroll
            for (int bj = 0; bj < 2; ++bj) { const int q = col0 + bj * HALF, n = q >> 7, l1 = q & 127;
                bf16_t* dst = Yp + ((size_t)(ka * 1024 + n) * 2) * 128 + l1;
                float2 t = t0;
#pragma unroll
                for (int nn = 0; nn < 2; ++nn) {
                    float yr[4], yi[4];
#pragma unroll
                    for (int e = 0; e < 4; ++e) { const float a = acc[0][bj][m][nn][e], b = acc[1][bj][m][nn][e];
                        yr[e] = a * t.x + b * t.y; yi[e] = b * t.x - a * t.y;
                        const float tx = t.x * st.x - t.y * st.y, ty = t.x * st.y + t.y * st.x; t.x = tx; t.y = ty; }
                    u32x2 o; o.x = pk2(yr[0], yr[1]); o.y = pk2(yr[2], yr[3]);
                    u32x2 p; p.x = pk2(yi[0], yi[1]); p.y = pk2(yi[2], yi[3]);
                    *(u32x2*)(dst + 4 * nn) = o; *(u32x2*)(dst + 128 + 4 * nn) = p; }
                __builtin_amdgcn_sched_barrier(0); } }
    }
};
struct EpiStep2 {
    static constexpr bool PERM = false, AFTER_DRAIN = false; float* X; const float* gate; const float* Xin;
    __device__ __forceinline__ void operator()(const Acc& acc, const Unit& u, int wr, int wc, int fr, int fq) const {
        const int col0 = u.pn * BM + wc * 32 + 4 * fq;
#pragma unroll
        for (int m = 0; m < 4; ++m) { const int kb = wr * 64 + m * 16 + fr;
#pragma unroll
            for (int bj = 0; bj < 2; ++bj)
#pragma unroll
                for (int n = 0; n < 2; ++n) { const int q = col0 + bj * HALF + n * 16, ka = q >> 10, nn = q & 1023;
                    const f32x4 g = *(const f32x4*)(gate + nn) * (1.f / 2048.f);
                    const size_t o = (size_t)(ka + 128 * kb) * D + nn; *(f32x4*)(X + o) = *(const f32x4*)(Xin + o) + g * acc[0][bj][m][n]; }
            if (m & 1) __builtin_amdgcn_sched_barrier(0); }
    }
};
struct EpiCtxDft {
    static constexpr bool PERM = false, AFTER_DRAIN = false; float* X; const float* gate;
    __device__ __forceinline__ void operator()(const Acc& acc, const Unit& u, int wr, int wc, int fr, int fq) const {
        const int row0 = wr * 64 + fr, col0 = u.pn * BM + wc * 32 + 4 * fq;
#pragma unroll
        for (int bj = 0; bj < 2; ++bj)
#pragma unroll
            for (int n = 0; n < 2; ++n) { const int col = col0 + bj * HALF + n * 16;
                const f32x4 g = *(const f32x4*)(gate + col) * (1.f / 256.f);
#pragma unroll
                for (int ai = 0; ai < 2; ++ai)
#pragma unroll
                    for (int m = 0; m < 4; ++m) { f32x4* p = (f32x4*)(X + (size_t)(SEQ + row0 + ai * HALF + m * 16) * D + col); *p = *p + g * acc[ai][bj][m][n]; }
                __builtin_amdgcn_sched_barrier(0); }
    }
};
struct EpiPool {
    static constexpr bool PERM = false, AFTER_DRAIN = false; float* X; const float* gate; const float* scale;
    __device__ __forceinline__ void operator()(const Acc& acc, const Unit& u, int wr, int wc, int fr, int fq) const {
        const int g = u.pn, row0 = (u.pm - 64 * g) * BM + wr * 64 + fr, col0 = g * BM + wc * 32 + 4 * fq;
#pragma unroll
        for (int bj = 0; bj < 2; ++bj)
#pragma unroll
            for (int n = 0; n < 2; ++n) { const int col = col0 + bj * HALF + n * 16;
                const f32x4 gv = *(const f32x4*)(gate + col) * *(const f32x4*)(scale + col);
#pragma unroll
                for (int ai = 0; ai < 2; ++ai)
#pragma unroll
                    for (int m = 0; m < 4; ++m) { f32x4* p = (f32x4*)(X + (size_t)(row0 + ai * HALF + m * 16) * D + col); *p = *p + gv * acc[ai][bj][m][n]; }
                __builtin_amdgcn_sched_barrier(0); }
    }
};

__device__ __forceinline__ void transpose_item(const float* W, int K, int N, bf16_t* WT, int mode, LAS float* scr, int item, int lane) {
    const int nblk = N / 32, kb = item / nblk, nb = item % nblk, k0 = 64 * kb, n0 = 32 * nb;
#pragma unroll 8
    for (int i = 0; i < 32; ++i) { const int kk = 2 * i + (lane >> 5); scr[kk * 33 + (lane & 31)] = W[(size_t)(k0 + kk) * N + n0 + (lane & 31)]; }
    asm volatile("s_waitcnt lgkmcnt(0)" ::: "memory");
    int r0 = n0;
    if (mode == 1) { const int half = n0 / DFF, t = n0 % DFF; r0 = (t / 128) * 256 + half * 128 + (t % 128); }
    const int c = lane & 7;
#pragma unroll
    for (int j = 0; j < 4; ++j) { const int n = (lane >> 3) + 8 * j; const LAS float* s = scr + (8 * c) * 33 + n;
        u32x4 o; o.x = pk2(s[0 * 33], s[1 * 33]); o.y = pk2(s[2 * 33], s[3 * 33]); o.z = pk2(s[4 * 33], s[5 * 33]); o.w = pk2(s[6 * 33], s[7 * 33]);
        *(u32x4*)(WT + (size_t)(r0 + n) * K + k0 + 8 * c) = o; }
    asm volatile("s_waitcnt lgkmcnt(0)" ::: "memory");
}

struct TDesc { const float* src; bf16_t* dst; int K, N; };
constexpr int TR_WI = 16 * 224, TR_WO = 56 * 32, TR_QKV = 16 * 48, TR_AO = 16 * 32, TR_PW = 4 * 8, TR_FW = 16 * 32;
constexpr int TR_NIT = 8 * TR_WI + 8 * TR_WO + TR_WI + TR_WO + TR_QKV + TR_AO + 2 * TR_FW + 4 * TR_PW;
constexpr int TR_DEF_DENSE = TR_WI + TR_WO, TR_DEF = TR_DEF_DENSE + 8 * TR_WI + 8 * TR_WO, DCH = 8;
__device__ __forceinline__ TDesc tr_mk(const float* W, int K, int N, bf16_t* WT, int mode, int item) {
    const int nblk = N / 32, kb = item / nblk, nb = item % nblk, k0 = 64 * kb, n0 = 32 * nb;
    int r0 = n0;
    if (mode == 1) { const int half = n0 / DFF, t = n0 % DFF; r0 = (t / 128) * 256 + half * 128 + (t % 128); }
    TDesc d; d.src = W + (size_t)k0 * N + n0; d.dst = WT + (size_t)r0 * K + k0; d.K = K; d.N = N; return d;
}
__device__ __forceinline__ TDesc tr_decode(const Params& P, unsigned char* ws, int it, int deferred) {
    int r = it;
    if (deferred) {
        if (r < TR_WI) return tr_mk(P.ffn_wi + (size_t)1024 * 7168, 1024, 7168, (bf16_t*)(ws + O_FWI) + (size_t)7168 * 1024, 1, r); r -= TR_WI;
        if (r < TR_WO) return tr_mk(P.ffn_wo + (size_t)3584 * 1024, 3584, 1024, (bf16_t*)(ws + O_FWO) + (size_t)1024 * 3584, 0, r); r -= TR_WO;
        if (r < 8 * TR_WI) { const int e = 8 + r / TR_WI; return tr_mk(P.moe_wi + (size_t)e * 1024 * 7168, 1024, 7168, (bf16_t*)(ws + O_MWI) + (size_t)e * 7168 * 1024, 1, r % TR_WI); } r -= 8 * TR_WI;
        { const int e = 8 + r / TR_WO; return tr_mk(P.moe_wo + (size_t)e * 3584 * 1024, 3584, 1024, (bf16_t*)(ws + O_MWO) + (size_t)e * 1024 * 3584, 0, r % TR_WO); }
    }
    if (r < 8 * TR_WI) { const int e = r / TR_WI; return tr_mk(P.moe_wi + (size_t)e * 1024 * 7168, 1024, 7168, (bf16_t*)(ws + O_MWI) + (size_t)e * 7168 * 1024, 1, r % TR_WI); } r -= 8 * TR_WI;
    if (r < 8 * TR_WO) { const int e = r / TR_WO; return tr_mk(P.moe_wo + (size_t)e * 3584 * 1024, 3584, 1024, (bf16_t*)(ws + O_MWO) + (size_t)e * 1024 * 3584, 0, r % TR_WO); } r -= 8 * TR_WO;
    if (r < TR_WI) return tr_mk(P.ffn_wi, 1024, 7168, (bf16_t*)(ws + O_FWI), 1, r); r -= TR_WI;
    if (r < TR_WO) return tr_mk(P.ffn_wo, 3584, 1024, (bf16_t*)(ws + O_FWO), 0, r); r -= TR_WO;
    if (r < TR_QKV) return tr_mk(P.wqkv, 1024, 1536, (bf16_t*)(ws + O_WQKV), 0, r); r -= TR_QKV;
    if (r < TR_AO) return tr_mk(P.attn_wo, 1024, 1024, (bf16_t*)(ws + O_WO), 0, r); r -= TR_AO;
    if (r < 2 * TR_FW) { const int j = r / TR_FW; return tr_mk(P.fnet_w + (size_t)j * 1024 * 1024, 1024, 1024, (bf16_t*)(ws + O_FWT) + (size_t)j * 1024 * 1024, 0, r % TR_FW); } r -= 2 * TR_FW;
    const int g = r / TR_PW; return tr_mk(P.pool_w + (size_t)g * 65536, 256, 256, (bf16_t*)(ws + O_POOLW) + (size_t)g * 65536, 0, r % TR_PW);
}
__device__ __forceinline__ void tr_load(const TDesc& d, float (&v)[32], int lane) {
    const float* p = d.src + (size_t)(lane >> 5) * d.N + (lane & 31);
#pragma unroll
    for (int i = 0; i < 32; ++i) v[i] = __builtin_nontemporal_load(p + (size_t)(2 * i) * d.N);
}
__device__ __forceinline__ void tr_store(const TDesc& d, const float (&v)[32], LAS float* scr, int lane) {
#pragma unroll
    for (int i = 0; i < 32; ++i) scr[(2 * i + (lane >> 5)) * 33 + (lane & 31)] = v[i];
    asm volatile("s_waitcnt lgkmcnt(0)" ::: "memory");
    const int c = lane & 7;
#pragma unroll
    for (int j = 0; j < 4; ++j) { const int n = (lane >> 3) + 8 * j; const LAS float* s = scr + (8 * c) * 33 + n;
        u32x4 o; o.x = pk2(s[0 * 33], s[1 * 33]); o.y = pk2(s[2 * 33], s[3 * 33]); o.z = pk2(s[4 * 33], s[5 * 33]); o.w = pk2(s[6 * 33], s[7 * 33]);
        *(u32x4*)(d.dst + (size_t)n * d.K + 8 * c) = o; }
    asm volatile("s_waitcnt lgkmcnt(0)" ::: "memory");
}

__device__ __forceinline__ void prep_phase(const Params& P, LAS unsigned char* lds) {
    const int tid = get_tid(), wave = tid >> 6, lane = tid & 63;
    unsigned char* ws = P.ws;
    const int gtid = get_bid() * NTHR + tid, gthreads = gridDim.x * NTHR;
    if (gtid < 16) ((int*)(ws + O_CTL))[gtid * CSTR] = 0;
    for (int t = gtid; t < 16384; t += gthreads) { float s, c; sincospif((float)t * (1.f / 8192.f), &s, &c); ((float2*)(ws + O_TW))[t] = make_float2(c, s); }
    for (int t = gtid; t < 256 * 16; t += gthreads) { const int pos = t >> 4, i = t & 15; const float inv = powf(10000.f, -(float)(2 * i) / 32.f); float s, c; sincosf((float)pos * inv, &s, &c); ((float2*)(ws + O_ROPE))[t] = make_float2(c, s); }
    for (int t = gtid; t < 256 * 256; t += gthreads) {
        const int r = t >> 8, cc = t & 255, cp = r >> 7, k = r & 127, c = cc >> 7, l = cc & 127; float s, co; sincospif((float)((k * l) & 127) * (1.f / 64.f), &s, &co);
        const float v1 = (cp == c) ? co : (cp == 0 ? s : -s);
        ((bf16_t*)(ws + O_FM1))[t] = (bf16_t)(pk2(v1, 0.f) & 0xFFFF);
        const float v2 = (cp == 0) ? (c == 0 ? co : s) : 0.f;
        ((bf16_t*)(ws + O_FM2))[t] = (bf16_t)(pk2(v2, 0.f) & 0xFFFF);
    }
    for (int t = gtid; t < 256 * 512; t += gthreads) {
        const int k = t >> 9, cc = t & 511, c = cc >> 8, l = cc & 255; float s, co; sincospif((float)((k * l) & 255) * (1.f / 128.f), &s, &co);
        ((bf16_t*)(ws + O_FC))[t] = (bf16_t)(pk2(c == 0 ? co : s, 0.f) & 0xFFFF);
    }
    for (int t = gtid; t < 512 * 256; t += gthreads) {
        const int r = t >> 8, mp = t & 255, c = r >> 8, ch = r & 255; float sn, co; sincospif((float)((ch * mp) & 255) * (1.f / 128.f), &sn, &co);
        ((bf16_t*)(ws + O_TMAT))[t] = (bf16_t)(pk2(c == 0 ? co : -sn, 0.f) & 0xFFFF);
    }
    { const f32x4* cs = (const f32x4*)P.ctx; f32x4* xd = (f32x4*)(ws + O_XRES);
      for (int t = gtid; t < CTXL * 256; t += gthreads) xd[SEQ * 256 + t] = cs[t]; }
    {
        LAS float* sc = (LAS float*)lds;
        LAS float* red = (LAS float*)(lds + 8192);
        for (int t = tid; t < 1024; t += NTHR) { sc[t] = silu_f(P.c[t]); sc[1024 + t] = silu_f(P.c_ctx[t]); }
        __syncthreads();
        for (int it = get_bid(); it < 192; it += gridDim.x) {
            const int i = it / 48, q = it % 48, col = 128 * q + 2 * lane;
            const float* wp = P.ada_w + (size_t)i * 1024 * 6144 + col;
            f32x2 a0 = {0, 0}, a1 = {0, 0};
#pragma unroll 16
            for (int kk = 0; kk < 128; ++kk) { const int k = wave * 128 + kk; const f32x2 w = *(const f32x2*)(wp + (size_t)k * 6144); a0 += sc[k] * w; a1 += sc[1024 + k] * w; }
            LAS float* rp = red + (wave * 64 + lane) * 4;
            rp[0] = a0[0]; rp[1] = a0[1]; rp[2] = a1[0]; rp[3] = a1[1];
            __syncthreads();
            if (wave == 0) {
                float s[4] = {0.f, 0.f, 0.f, 0.f};
#pragma unroll
                for (int w = 0; w < 8; ++w)
#pragma unroll
                    for (int e = 0; e < 4; ++e) s[e] += red[(w * 64 + lane) * 4 + e];
                const f32x2 bb = *(const f32x2*)(P.ada_b + i * 6144 + col);
                float* o0 = (float*)(ws + O_ADA) + (size_t)(i * 2 + 0) * 6144 + col; float* o1 = (float*)(ws + O_ADA) + (size_t)(i * 2 + 1) * 6144 + col;
                *(f32x2*)o0 = (f32x2){s[0] + bb[0], s[1] + bb[1]};
                *(f32x2*)o1 = (f32x2){s[2] + bb[0], s[3] + bb[1]};
            }
            __syncthreads();
        }
    }
    __syncthreads();
    {
        LAS float* scr = (LAS float*)(lds + wave * 8448);
        const int gw = get_bid() * NWAVE + wave, ngw = gridDim.x * NWAVE;
        int it = gw;
        float v[32]; TDesc cur;
        if (it < TR_NIT) { cur = tr_decode(P, ws, it, 0); tr_load(cur, v, lane); }
        while (it < TR_NIT) {
            const int nit = it + ngw; float w[32]; TDesc nx = cur;
            if (nit < TR_NIT) { nx = tr_decode(P, ws, nit, 0); tr_load(nx, w, lane); }
            tr_store(cur, v, scr, lane);
#pragma unroll
            for (int i = 0; i < 32; ++i) v[i] = w[i];
            cur = nx; it = nit;
        }
    }
}

__device__ __forceinline__ void deferred_work(const Params& P, LAS unsigned char* lds, int maxclaims, int units, int limit_items) {
    const int tid = get_tid(), wave = tid >> 6, lane = tid & 63;
    unsigned char* ws = P.ws;
    LAS float* scr = (LAS float*)(lds + wave * 8448); volatile LAS int* sc = (volatile LAS int*)(lds + 8 * 8448);
    unsigned* ctr = (unsigned*)(ws + O_BAR) + 3600;
    for (int n = 0; n < maxclaims; ++n) {
        __syncthreads();
        if (tid == 0) { int c = -1; const unsigned cur = __hip_atomic_load(ctr, __ATOMIC_RELAXED, __HIP_MEMORY_SCOPE_AGENT);
            const int stop = limit_items > 0 ? limit_items : TR_DEF;
            if ((int)cur * DCH < stop) c = (int)atomicAdd(ctr, (unsigned)units);
            *sc = c; }
        __syncthreads();
        const int c = *sc, base = c * DCH;
        if (c < 0 || base >= TR_DEF) break;
        const int cend = base + units * DCH, i1 = cend < TR_DEF ? cend : TR_DEF;
        int it = base + wave;
        float v[32]; TDesc cur;
        if (it < i1) { cur = tr_decode(P, ws, it, 1); tr_load(cur, v, lane); }
        while (it < i1) {
            const int nit = it + NWAVE; float w[32]; TDesc nx = cur;
            if (nit < i1) { nx = tr_decode(P, ws, nit, 1); tr_load(nx, w, lane); }
            tr_store(cur, v, scr, lane);
#pragma unroll
            for (int i = 0; i < 32; ++i) v[i] = w[i];
            cur = nx; it = nit;
        }
    }
    __syncthreads();
}

__device__ __forceinline__ void norm_phase(const Params& P, LAS unsigned char* lds, int layer, int which, int nrows, int flags, int fprev, int fnext, const float* g2ovr, const float* xsrc, const float* gcp) {
    const int tid = get_tid(), wave = tid >> 6, lane = tid & 63;
    unsigned char* ws = P.ws;
    float* xres = (float*)(ws + O_XRES);
    bf16_t* hbuf = (bf16_t*)(ws + O_HBUF);
    const float* ada = (const float*)(ws + O_ADA);
    const int gw = get_bid() * NWAVE + wave, ngw = gridDim.x * NWAVE;
    LAS float* rt = (LAS float*)lds;
    LAS int* etab = (LAS int*)(lds + 32768);
    LAS int* rtab = (LAS int*)(lds + 32768 + 8192);
    if (flags & 2) { const float* rp = P.router + (size_t)fnext * 1024 * 8; for (int t = tid; t < 8192; t += NTHR) rt[t] = rp[t]; for (int t = tid; t < 2048; t += NTHR) etab[t] = -1; __syncthreads(); }
    const float* g2p = nullptr;
    if (flags & 4) {
        g2p = g2ovr ? g2ovr : ada + (size_t)((layer - 1) * 2 + 0) * 6144 + 5 * 1024;
    }
    const float2* rw = (const float2*)(ws + O_RW);
    const bf16_t* ysb = (const bf16_t*)(ws + O_YS); const float* ysp = (const float*)(ws + O_YSP);
    auto ldy = [&](int rowi, int j, int thr) -> f32x4 {
        if (rowi < thr) { const u32x2 raw = *((const u32x2*)(ysb + (size_t)rowi * D + 256 * j) + lane); return (f32x4){bflo(raw.x), bfhi(raw.x), bflo(raw.y), bfhi(raw.y)}; }
        f32x4 t[KSPL];
#pragma unroll
        for (int ks = 0; ks < KSPL; ++ks) t[ks] = *((const f32x4*)(ysp + ((size_t)ks * 2048 + (rowi - 32768)) * D + 256 * j) + lane);
        f32x4 a = t[0];
#pragma unroll
        for (int ks = 1; ks < KSPL; ++ks) a += t[ks];
        return a; };
    for (int pass = 0; pass < 2; ++pass) {
        const int rlo = pass == 0 ? 0 : SEQ, rhi = pass == 0 ? (nrows < SEQ ? nrows : SEQ) : nrows;
        if (rlo >= rhi || (pass == 0 && (flags & 32))) continue;
        f32x4 ga[4], sh[4], g2[4];
        if (!(flags & 8)) {
            const float* gain = (which == 0 ? P.norm_mix : P.norm_ffn) + layer * 1024;
            const float* ap = ada + (size_t)(layer * 2 + pass) * 6144 + (which == 0 ? 0 : 3 * 1024);
#pragma unroll
            for (int j = 0; j < 4; ++j) { const int col = 4 * lane + 256 * j; ga[j] = *(const f32x4*)(gain + col) * (1.f + *(const f32x4*)(ap + 1024 + col)); sh[j] = *(const f32x4*)(ap + col); }
        }
        if (flags & 4) {
#pragma unroll
            for (int j = 0; j < 4; ++j) g2[j] = *(const f32x4*)(g2p + 4 * lane + 256 * j);
        }
        int2 nsr = make_int2(0, 0); float2 nw = make_float2(0.f, 0.f);
        if ((flags & 4) && rlo + gw < rhi) { nsr = ((const int2*)(ws + O_SROW))[rlo + gw]; nw = rw[rlo + gw]; }
        for (int r = rlo + gw; r < rhi; r += ngw) {
            f32x4 v[4];
            const f32x4* xr = (const f32x4*)((r < SEQ ? xsrc : xres) + (size_t)r * D) + lane;
#pragma unroll
            for (int j = 0; j < 4; ++j) v[j] = xr[64 * j];
            if (flags & 4) {
                const int2 sr = nsr; const float2 w = nw;
                if (r + ngw < rhi) { nsr = ((const int2*)(ws + O_SROW))[r + ngw]; nw = rw[r + ngw]; }
                const int r0 = sr.x, r1 = sr.y;
#pragma unroll
                for (int j = 0; j < 4; ++j) v[j] = v[j] + g2[j] * (w.x * ldy(r0, j, MOE_SPLIT ? 32768 : (1 << 30)) + w.y * ldy(r1, j, MOE_SPLIT ? 32768 : (1 << 30)));
                f32x4* xo = (f32x4*)(((flags & 8) ? P.out : xres) + (size_t)r * D) + lane;
#pragma unroll
                for (int j = 0; j < 4; ++j) xo[64 * j] = v[j];
            }
            if ((flags & 16) && r >= SEQ) {
#pragma unroll
                for (int j = 0; j < 4; ++j) v[j] = v[j] + *(const f32x4*)(gcp + 4 * lane + 256 * j) * ldy(32768 + r - SEQ, j, 32768);
                f32x4* xo = (f32x4*)(xres + (size_t)r * D) + lane;
#pragma unroll
                for (int j = 0; j < 4; ++j) xo[64 * j] = v[j];
            }
            if (flags & 8) continue;
            float ss = 0.f;
#pragma unroll
            for (int j = 0; j < 4; ++j) ss += (v[j][0] * v[j][0] + v[j][1] * v[j][1]) + (v[j][2] * v[j][2] + v[j][3] * v[j][3]);
            const float rstd = rsqrtf(wave_sum(ss) * (1.f / D) + 1e-6f);
#pragma unroll
            for (int j = 0; j < 4; ++j) v[j] = v[j] * rstd * ga[j] + sh[j];
            int orow = r;
            if ((flags & 1) && r < SEQ) orow = 128 * (r & 127) + (r >> 7);
            u32x2* o8 = (u32x2*)(hbuf + (size_t)orow * D) + lane;
#pragma unroll
            for (int j = 0; j < 4; ++j) { u32x2 o; o.x = pk2(v[j][0], v[j][1]); o.y = pk2(v[j][2], v[j][3]); o8[64 * j] = o; }
            if (flags & 2) {
                float lg[8];
#pragma unroll
                for (int e = 0; e < 8; ++e) lg[e] = 0.f;
#pragma unroll
                for (int j = 0; j < 4; ++j)
#pragma unroll
                    for (int e = 0; e < 4; ++e) { const LAS f32x4* rr = (const LAS f32x4*)(rt + (4 * lane + 256 * j + e) * 8); const f32x4 r0 = rr[0], r1 = rr[1]; const float hv = v[j][e];
                        lg[0] += hv * r0[0]; lg[1] += hv * r0[1]; lg[2] += hv * r0[2]; lg[3] += hv * r0[3]; lg[4] += hv * r1[0]; lg[5] += hv * r1[1]; lg[6] += hv * r1[2]; lg[7] += hv * r1[3]; }
#pragma unroll
                for (int e = 0; e < 8; ++e) lg[e] = wave_sum(lg[e]);
                int e0 = 0; float v0 = lg[0];
#pragma unroll
                for (int e = 1; e < 8; ++e) if (lg[e] > v0) { v0 = lg[e]; e0 = e; }
                int e1 = -1; float v1 = -3.0e38f;
#pragma unroll
                for (int e = 0; e < 8; ++e) if (e != e0 && lg[e] > v1) { v1 = lg[e]; e1 = e; }
                if (lane == 0) {
                    const int rho = ((r - gw) / ngw) * NWAVE + wave;
                    etab[2 * rho] = e0; etab[2 * rho + 1] = e1;
                    const float ex = __expf(v1 - v0), w0 = 1.f / (1.f + ex);
                    ((float2*)(ws + O_RW))[r] = make_float2(w0, ex * w0);
                }
            }
        }
    }
    if (flags & 2) {
        __syncthreads();
        const int nent = 2 * NWAVE * ((SEQ + ngw - 1) / ngw);
        if (wave == 0) {
            int run[NEXP];
#pragma unroll
            for (int e = 0; e < NEXP; ++e) run[e] = 0;
            for (int base = 0; base < nent; base += 64) {
                const int i = base + lane, ee = etab[i]; int myrank = 0;
#pragma unroll
                for (int e = 0; e < NEXP; ++e) { const unsigned long long mask = __ballot(ee == e); if (ee == e) myrank = run[e] + __popcll(mask & ((1ull << lane) - 1ull)); run[e] += __popcll(mask); }
                rtab[i] = myrank;
            }
            int mine = 0;
#pragma unroll
            for (int e = 0; e < NEXP; ++e) if (lane == e) mine = run[e];
            if (lane < NEXP) ((int*)(ws + O_BLK))[get_bid() * NEXP + lane] = mine;
        }
        __syncthreads();
        if (lane == 0) {
            int4* route_w = (int4*)(ws + O_ROUTE);
            for (int r = gw; r < SEQ; r += ngw) { const int rho = ((r - gw) / ngw) * NWAVE + wave; route_w[r] = make_int4(etab[2 * rho], rtab[2 * rho], etab[2 * rho + 1], rtab[2 * rho + 1]); }
        }
        __syncthreads();
    }
}

__device__ __forceinline__ void gather_phase(const Params& P, LAS unsigned char* lds, int f) {
    const int tid = get_tid(), wave = tid >> 6, lane = tid & 63;
    unsigned char* ws = P.ws;
    const int gw = get_bid() * NWAVE + wave, ngw = gridDim.x * NWAVE, nb = gridDim.x;
    LAS int* pre = (LAS int*)lds;
    LAS int* tot = (LAS int*)(lds + 32768);
    const int* blk = (const int*)(ws + O_BLK);
    __syncthreads();
    for (int t = tid; t < nb * NEXP; t += NTHR) pre[t] = blk[t];
    __syncthreads();
    {
        const int e = wave; int c[4], sum = 0;
#pragma unroll
        for (int j = 0; j < 4; ++j) { const int b = 4 * lane + j; c[j] = (b < nb) ? pre[b * NEXP + e] : 0; sum += c[j]; }
        int incl = sum;
#pragma unroll
        for (int o = 1; o < 64; o <<= 1) { const int t = __shfl_up(incl, o); if (lane >= o) incl += t; }
        int run = incl - sum; const int total = __shfl(incl, 63);
#pragma unroll
        for (int j = 0; j < 4; ++j) { const int b = 4 * lane + j; if (b < nb) { pre[b * NEXP + e] = run; run += c[j]; } }
        if (lane == 0) { tot[e] = total; if (get_bid() == 0) ((int*)(ws + O_CTL))[(f * 8 + e) * CSTR] = total; }
    }
    __syncthreads();
    int off[NEXP], cn[NEXP]; { int a = 0;
#pragma unroll
        for (int e = 0; e < NEXP; ++e) { cn[e] = tot[e]; off[e] = a; a += ((cn[e] + 255) >> 8) << 8; } }
    const int4* route = (const int4*)(ws + O_ROUTE);
    int* inv = (int*)(ws + O_INV);
    for (int t = get_bid() * NTHR + tid; t < SEQ; t += nb * NTHR) {
        const int4 ro = route[t]; const int b = (t % ngw) / NWAVE;
        int r0 = pre[b * NEXP + ro.x] + ro.y, r1 = pre[b * NEXP + ro.z] + ro.w;
#pragma unroll
        for (int e = 0; e < NEXP; ++e) { if (ro.x == e) r0 += off[e]; if (ro.z == e) r1 += off[e]; }
        ((int2*)(ws + O_SROW))[t] = make_int2(r0, r1);
        inv[r0] = t; inv[r1] = t;
    }
#pragma unroll
    for (int e = 0; e < NEXP; ++e) {
        const int lo = off[e] + cn[e], hi = off[e] + (((cn[e] + 255) >> 8) << 8);
        for (int r = lo + get_bid() * NTHR + tid; r < hi; r += nb * NTHR) inv[r] = 0;
    }
    __syncthreads();
}

__device__ __forceinline__ void qkpost_phase(const Params& P) {
    const int tid = get_tid(), wave = tid >> 6, lane = tid & 63;
    unsigned char* ws = P.ws;
    const int gw = get_bid() * NWAVE + wave, ngw = gridDim.x * NWAVE;
    bf16_t* qk = (bf16_t*)(ws + O_QK); const float2* rope = (const float2*)(ws + O_ROPE);
    const int sub = lane & 15, d0 = 4 * sub;
    const f32x4 gq = *(const f32x4*)(P.q_gain + d0), gk = *(const f32x4*)(P.k_gain + d0);
    for (int r = gw; r < MTOT; r += ngw) {
        const int pos = (sub < 8) ? (r >> 6) : (r & 63);
        float2 cs[4];
#pragma unroll
        for (int e = 0; e < 4; ++e) cs[e] = rope[(pos & 255) * 16 + 4 * (sub & 3) + e];
#pragma unroll
        for (int p = 0; p < 5; ++p) {
            const int hh = 4 * p + (lane >> 4); const bool isq = hh < 16;
            u32x2* ptr = (u32x2*)(qk + (size_t)r * 1280 + hh * 64 + d0);
            const u32x2 raw = *ptr;
            float y[4] = {bflo(raw.x), bfhi(raw.x), bflo(raw.y), bfhi(raw.y)};
            float ss = (y[0] * y[0] + y[1] * y[1]) + (y[2] * y[2] + y[3] * y[3]);
            ss += __shfl_xor(ss, 1); ss += __shfl_xor(ss, 2); ss += __shfl_xor(ss, 4); ss += __shfl_xor(ss, 8);
            const float rs = rsqrtf(ss * (1.f / 64.f) + 1e-6f) * (isq ? 0.125f : 1.f);
            const f32x4 g = isq ? gq : gk;
#pragma unroll
            for (int e = 0; e < 4; ++e) y[e] = y[e] * rs * g[e];
            float py[4];
#pragma unroll
            for (int e = 0; e < 4; ++e) py[e] = __shfl_xor(y[e], 4);
            if (r < SEQ) {
#pragma unroll
                for (int e = 0; e < 4; ++e) y[e] = (sub & 4) ? (py[e] * cs[e].y + y[e] * cs[e].x) : (y[e] * cs[e].x - py[e] * cs[e].y);
            }
            if (r < SEQ || !isq) { u32x2 o; o.x = pk2(y[0], y[1]); o.y = pk2(y[2], y[3]); *ptr = o; }
        }
    }
}

__device__ __forceinline__ void attn_chunk(LAS unsigned char* Kl, LAS unsigned char* Vl, const bf16x8 (&qf)[4], f32x16 (&o)[2], float& m, float& l, int q, int half, int ii, int maskmode) {
    f32x16 s[2];
#pragma unroll
    for (int kb = 0; kb < 2; ++kb) {
#pragma unroll
        for (int r = 0; r < 16; ++r) s[kb][r] = 0.f;
#pragma unroll
        for (int ks = 0; ks < 4; ++ks) { const bf16x8 kf = *(const LAS bf16x8*)(Kl + (32 * kb + q) * 144 + (2 * ks + half) * 16); s[kb] = __builtin_amdgcn_mfma_f32_32x32x16_bf16(kf, qf[ks], s[kb], 0, 0, 0); }
    }
    if (maskmode != 0) {
#pragma unroll
        for (int kb = 0; kb < 2; ++kb)
#pragma unroll
            for (int r = 0; r < 16; ++r) { const int jj = 32 * kb + 8 * (r >> 2) + 4 * half + (r & 3); const bool ok = (maskmode == 1) ? (jj >= ii) : (jj <= ii); if (!ok) s[kb][r] = -1e30f; }
    }
    float mx = s[0][0];
#pragma unroll
    for (int kb = 0; kb < 2; ++kb)
#pragma unroll
        for (int r = 0; r < 16; ++r) mx = fmaxf(mx, s[kb][r]);
    mx = fmaxf(mx, __shfl_xor(mx, 32));
    const float mn = fmaxf(m, mx), alpha = __expf(m - mn);
    float ps = 0.f;
#pragma unroll
    for (int kb = 0; kb < 2; ++kb)
#pragma unroll
        for (int r = 0; r < 16; ++r) { const float p = __expf(s[kb][r] - mn); s[kb][r] = p; ps += p; }
    l = l * alpha + ps; m = mn;
#pragma unroll
    for (int db = 0; db < 2; ++db)
#pragma unroll
        for (int r = 0; r < 16; ++r) o[db][r] *= alpha;
#pragma unroll
    for (int kb = 0; kb < 2; ++kb)
#pragma unroll
        for (int t = 0; t < 2; ++t) {
            union { bf16x8 v; unsigned u[4]; } pf;
#pragma unroll
            for (int i = 0; i < 4; ++i) pf.u[i] = pk2(s[kb][8 * t + 2 * i], s[kb][8 * t + 2 * i + 1]);
#pragma unroll
            for (int db = 0; db < 2; ++db) {
                union { bf16x8 v; u32x2 h[2]; } vf;
                const LAS unsigned char* vp = Vl + (32 * db + q) * 136 + (32 * kb + 16 * t + 4 * half) * 2;
                vf.h[0] = *(const LAS u32x2*)vp; vf.h[1] = *(const LAS u32x2*)(vp + 16);
                o[db] = __builtin_amdgcn_mfma_f32_32x32x16_bf16(vf.v, pf.v, o[db], 0, 0, 0);
            }
        }
}
__device__ __forceinline__ void attn_stage(LAS unsigned char* Kl, LAS unsigned char* Vl, const bf16_t* qk, const bf16_t* Vt, int tok0, int g, int tid, const float* kgain, const float2* rope, bool do_rope) {
    const int row = tid >> 3, piece = tid & 7;
    const u32x4 kraw = *(const u32x4*)(qk + (size_t)(tok0 + row) * 1280 + 1024 + 64 * g + 8 * piece);
    float y[8] = {bflo(kraw.x), bfhi(kraw.x), bflo(kraw.y), bfhi(kraw.y), bflo(kraw.z), bfhi(kraw.z), bflo(kraw.w), bfhi(kraw.w)};
    float ss = 0.f;
#pragma unroll
    for (int i = 0; i < 8; ++i) ss += y[i] * y[i];
    ss += __shfl_xor(ss, 1); ss += __shfl_xor(ss, 2); ss += __shfl_xor(ss, 4);
    const float rs = rsqrtf(ss * (1.f / 64.f) + 1e-6f);
    const f32x4 g0 = *(const f32x4*)(kgain + 8 * piece), g1 = *(const f32x4*)(kgain + 8 * piece + 4);
#pragma unroll
    for (int i = 0; i < 4; ++i) { y[i] *= rs * g0[i]; y[4 + i] *= rs * g1[i]; }
    float py[8];
#pragma unroll
    for (int i = 0; i < 8; ++i) py[i] = __shfl_xor(y[i], 2);
    if (do_rope) {
        const int token = tok0 + row, pos = (piece < 4) ? (token >> 6) : (token & 63);
        const float2* cs = rope + pos * 16 + 8 * (piece & 1);
#pragma unroll
        for (int i = 0; i < 8; ++i) { const float2 t = cs[i]; y[i] = (piece & 2) ? (py[i] * t.y + y[i] * t.x) : (y[i] * t.x - py[i] * t.y); }
    }
    u32x4 kv; kv.x = pk2(y[0], y[1]); kv.y = pk2(y[2], y[3]); kv.z = pk2(y[4], y[5]); kv.w = pk2(y[6], y[7]);
    *(LAS u32x4*)(Kl + row * 144 + piece * 16) = kv;
    const u32x4 vv = *(const u32x4*)(Vt + (size_t)(g * 64 + row) * MTOT + tok0 + 8 * piece);
    LAS u32x2* vd = (LAS u32x2*)(Vl + row * 136 + piece * 16); vd[0] = (u32x2){vv.x, vv.y}; vd[1] = (u32x2){vv.z, vv.w};
}
__device__ __forceinline__ void attn_phase(const Params& P, LAS unsigned char* lds) {
    const int tid = get_tid(), wave = tid >> 6, lane = tid & 63, q = lane & 31, half = lane >> 5;
    unsigned char* ws = P.ws;
    const bf16_t* qk = (const bf16_t*)(ws + O_QK); const bf16_t* Vt = (const bf16_t*)(ws + O_VT); bf16_t* ao = (bf16_t*)(ws + O_AO);
    const float2* rope = (const float2*)(ws + O_ROPE);
    constexpr int KSZ = 64 * 144, VSZ = 64 * 136, VBASE = 5 * KSZ;
    for (int unit = get_bid(); unit < 1024; unit += gridDim.x) {
        const int qb = unit >> 2, g = unit & 3, h = 4 * g + (wave >> 1), ii = 32 * (wave & 1) + q, tok = 64 * qb + ii;
        bf16x8 qf[4];
        {
            float yq[4][8]; float ss = 0.f;
#pragma unroll
            for (int ks = 0; ks < 4; ++ks) { const u32x4 raw = *(const u32x4*)(qk + (size_t)tok * 1280 + h * 64 + 16 * ks + 8 * half);
                yq[ks][0] = bflo(raw.x); yq[ks][1] = bfhi(raw.x); yq[ks][2] = bflo(raw.y); yq[ks][3] = bfhi(raw.y); yq[ks][4] = bflo(raw.z); yq[ks][5] = bfhi(raw.z); yq[ks][6] = bflo(raw.w); yq[ks][7] = bfhi(raw.w);
#pragma unroll
                for (int i = 0; i < 8; ++i) ss += yq[ks][i] * yq[ks][i]; }
            ss += __shfl_xor(ss, 32);
            const float rs = rsqrtf(ss * (1.f / 64.f) + 1e-6f) * 0.125f;
#pragma unroll
            for (int ks = 0; ks < 4; ++ks) { const f32x4 g0 = *(const f32x4*)(P.q_gain + 16 * ks + 8 * half), g1 = *(const f32x4*)(P.q_gain + 16 * ks + 8 * half + 4);
#pragma unroll
                for (int i = 0; i < 4; ++i) { yq[ks][i] *= rs * g0[i]; yq[ks][4 + i] *= rs * g1[i]; } }
            const float2* cr = rope + (tok >> 6) * 16 + 8 * half; const float2* cc = rope + (tok & 63) * 16 + 8 * half;
#pragma unroll
            for (int i = 0; i < 8; ++i) { const float2 tr = cr[i], tc = cc[i];
                const float a1 = yq[0][i], a2 = yq[1][i]; yq[0][i] = a1 * tr.x - a2 * tr.y; yq[1][i] = a1 * tr.y + a2 * tr.x;
                const float b1 = yq[2][i], b2 = yq[3][i]; yq[2][i] = b1 * tc.x - b2 * tc.y; yq[3][i] = b1 * tc.y + b2 * tc.x; }
#pragma unroll
            for (int ks = 0; ks < 4; ++ks) { union { bf16x8 v; unsigned u[4]; } pk;
#pragma unroll
                for (int i = 0; i < 4; ++i) pk.u[i] = pk2(yq[ks][2 * i], yq[ks][2 * i + 1]);
                qf[ks] = pk.v; }
        }
        float m = P.sink[h], l = (half == 0) ? 1.f : 0.f;
        f32x16 o[2];
#pragma unroll
        for (int db = 0; db < 2; ++db)
#pragma unroll
            for (int r = 0; r < 16; ++r) o[db][r] = 0.f;
#pragma unroll
        for (int ci = 0; ci < 5; ++ci) { const int cb = qb - 2 + ci; if (cb >= 0 && cb < SEQ / 64) attn_stage(lds + ci * KSZ, lds + VBASE + ci * VSZ, qk, Vt, 64 * cb, g, tid, P.k_gain, rope, true); }
        __syncthreads();
#pragma unroll
        for (int ci = 0; ci < 5; ++ci) { const int cb = qb - 2 + ci; if (cb >= 0 && cb < SEQ / 64) attn_chunk(lds + ci * KSZ, lds + VBASE + ci * VSZ, qf, o, m, l, q, half, ii, ci == 0 ? 1 : (ci == 4 ? 2 : 0)); }
        __syncthreads();
#pragma unroll
        for (int ci = 0; ci < 4; ++ci) attn_stage(lds + ci * KSZ, lds + VBASE + ci * VSZ, qk, Vt, SEQ + 64 * ci, g, tid, P.k_gain, rope, false);
        __syncthreads();
#pragma unroll
        for (int ci = 0; ci < 4; ++ci) attn_chunk(lds + ci * KSZ, lds + VBASE + ci * VSZ, qf, o, m, l, q, half, ii, 0);
        __syncthreads();
        const float lt = l + __shfl_xor(l, 32), inv = 1.f / lt;
        bf16_t* op = ao + (size_t)tok * D + h * 64;
#pragma unroll
        for (int db = 0; db < 2; ++db)
#pragma unroll
            for (int rg = 0; rg < 4; ++rg) { u32x2 ov; ov.x = pk2(o[db][4 * rg] * inv, o[db][4 * rg + 1] * inv); ov.y = pk2(o[db][4 * rg + 2] * inv, o[db][4 * rg + 3] * inv);
                *(u32x2*)(op + 32 * db + 8 * rg + 4 * half) = ov; }
    }
}

__device__ __forceinline__ void pool_phase(const Params& P) {
    const int tid = get_tid(), wave = tid >> 6, lane = tid & 63;
    unsigned char* ws = P.ws;
    const int gw = get_bid() * NWAVE + wave, ngw = gridDim.x * NWAVE;
    const bf16_t* hbuf = (const bf16_t*)(ws + O_HBUF); bf16_t* pl = (bf16_t*)(ws + O_POOL);
    for (int t = gw; t < SEQ; t += ngw) {
#pragma unroll
        for (int j = 0; j < 4; ++j) {
            const int w = 2 << j; int lo = t - (w >> 1), hi = t + (w >> 1) - 1; lo = lo < 0 ? 0 : lo; hi = hi > SEQ - 1 ? SEQ - 1 : hi;
            float s[4] = {0.f, 0.f, 0.f, 0.f};
            for (int tt = lo; tt <= hi; ++tt) { const u32x2 raw = *((const u32x2*)(hbuf + (size_t)tt * D + 256 * j) + lane); s[0] += bflo(raw.x); s[1] += bfhi(raw.x); s[2] += bflo(raw.y); s[3] += bfhi(raw.y); }
            const u32x2 self = *((const u32x2*)(hbuf + (size_t)t * D + 256 * j) + lane);
            const float ic = 1.f / (float)(hi - lo + 1);
            u32x2 o; o.x = pk2(s[0] * ic - bflo(self.x), s[1] * ic - bfhi(self.x)); o.y = pk2(s[2] * ic - bflo(self.y), s[3] * ic - bfhi(self.y));
            *((u32x2*)(pl + ((size_t)j * SEQ + t) * 256) + lane) = o;
        }
    }
}

enum { K_PREP, K_NORM, K_FGEMM, K_STEP1, K_STEP2, K_FFNWI, K_FFNWO, K_QKV, K_QKPOST, K_ATTN, K_ATTNWO, K_GATHER, K_MOEWI, K_MOEWO, K_POOL, K_POOLG, K_CTXDFT, K_FOLD, K_WOSPLIT, K_NONE };
constexpr int NPHASE = 32;

__global__ void __launch_bounds__(NTHR, 2) mega_fwd(Params P) {
    extern __shared__ __attribute__((aligned(16))) unsigned char smem[];
    LAS unsigned char* lds = (LAS unsigned char*)smem;
    unsigned char* ws = P.ws;
    const float* ada = (const float*)(ws + O_ADA);
    float* xres = (float*)(ws + O_XRES);
    volatile LAS unsigned* xst = (volatile LAS unsigned*)(lds + LDS_BYTES);
    if (threadIdx.x == 0) { xst[0] = 0u; xst[1] = 0u; }
    __syncthreads();
    const XcdBarrier xb = xcd_barrier_post((unsigned*)(ws + O_BAR), xst);
#ifndef REPEAT_MASK
#define REPEAT_MASK 0u
#endif

    for (int ph = P.ph_lo; ph < P.ph_hi; ++ph) {
      if (ph == 10) continue;
      if (ph == 20 || ph == 23) continue;
      const int nrep = ((REPEAT_MASK >> ph) & 1u) ? 2 : 1;
      for (int rep = 0; rep < nrep; ++rep) {
      if (rep > 0) xcd_barrier(xb);
      for (int sub = 0; sub < 2; ++sub) {
        if (rep > 0 && sub > 0) continue;
        int kind = K_NONE, layer = 0, a0 = 0, a1 = 0, a2 = 0, a3 = 0;
        if (sub == 0) {
        switch (ph) {
            case 0: kind = K_PREP; break;
            case 1: kind = K_NORM; layer = 0; a0 = 0; a1 = MTOT; a2 = 1; break;
            case 2: kind = K_FGEMM; layer = 0; a0 = 0; a1 = MTOT; break;
            case 3: kind = K_STEP1; layer = 0; break;
            case 4: kind = K_STEP2; layer = 0; break;
            case 5: kind = K_NORM; layer = 0; a0 = 1; a1 = MTOT; break;
            case 6: kind = K_FFNWI; a0 = 0; a1 = MTOT; break;
            case 7: kind = K_FFNWO; layer = 0; a0 = 0; a1 = SEQ; break;
            case 8: kind = K_NORM; layer = 1; a0 = 0; a1 = MTOT; a2 = 16 | 32; break;
            case 9: kind = K_QKV; break;
            case 10: kind = K_QKPOST; break;
            case 11: kind = K_ATTN; break;
            case 12: kind = K_ATTNWO; layer = 1; break;
            case 13: kind = K_NORM; layer = 1; a0 = 1; a1 = SEQ; a2 = 2; a3 = 0; break;
            case 14: kind = K_GATHER; a0 = 0; break;
            case 15: kind = K_MOEWI; a0 = 0; break;
            case 16: kind = K_MOEWO; a0 = 0; break;
            case 17: kind = K_NORM; layer = 2; a0 = 0; a1 = SEQ; a2 = 4; a3 = 0; break;
            case 18: kind = K_POOL; break;
            case 19: kind = K_POOLG; layer = 2; break;
            case 20: kind = K_NORM; layer = 2; a0 = 1; a1 = SEQ; break;
            case 21: kind = K_FFNWI; a0 = 1; a1 = SEQ; break;
            case 22: kind = K_FFNWO; layer = 2; a0 = 1; a1 = SEQ; break;
            case 23: kind = K_NORM; layer = 3; a0 = 0; a1 = SEQ; a2 = 1; break;
            case 24: kind = K_FGEMM; layer = 3; a0 = 1; a1 = SEQ; break;
            case 25: kind = K_STEP1; layer = 3; break;
            case 26: kind = K_STEP2; layer = 3; break;
            case 27: kind = K_NORM; layer = 3; a0 = 1; a1 = SEQ; a2 = 2; a3 = 1; break;
            case 28: kind = K_GATHER; a0 = 1; break;
            case 29: kind = K_MOEWI; a0 = 1; break;
            case 30: kind = K_MOEWO; a0 = 1; break;
            default: kind = K_NORM; layer = 4; a0 = 0; a1 = SEQ; a2 = 4 | 8; a3 = 1; break;
        }
        } else {
            if (ph == 1) { kind = K_FOLD; }
            else if (ph == 3) { kind = K_CTXDFT; layer = 0; }
            else if (ph == 9) { kind = K_QKV; a0 = 1; }
            else if (ph == 7) { kind = K_WOSPLIT; a0 = 0; a1 = 0; }
            else if (MOE_SPLIT && ph == 16) { kind = K_WOSPLIT; a0 = 0; a1 = 1; }
            else if (MOE_SPLIT && ph == 30) { kind = K_WOSPLIT; a0 = 1; a1 = 1; }
        }
        if (kind == K_NONE) continue;
        const float* zv = (const float*)(ws + O_ZERO);
        const int lyr = layer < 4 ? layer : 3;
        const float* gx1 = rep > 0 ? zv : ada + (size_t)(lyr * 2) * 6144 + 2 * 1024;
        const float* gx2 = rep > 0 ? zv : ada + (size_t)(lyr * 2) * 6144 + 5 * 1024;
        const float* gc1 = rep > 0 ? zv : ada + (size_t)(lyr * 2 + 1) * 6144 + 2 * 1024;
        const float* gc2 = rep > 0 ? zv : ada + (size_t)(lyr * 2 + 1) * 6144 + 5 * 1024;
#ifndef KIND_MASK
#define KIND_MASK 0xFFFFFF
#endif
#define KON(k) if (!((KIND_MASK >> (k)) & 1)) break;
        switch (kind) {
            case K_PREP: KON(K_PREP) prep_phase(P, lds); break;
            case K_NORM: KON(K_NORM) norm_phase(P, lds, layer, a0, a1, a2, a3, a3, rep > 0 ? zv : nullptr, (ph == 1) ? P.x : xres, rep > 0 ? zv : ada + (size_t)(0 * 2 + 1) * 6144 + 5 * 1024);
                break;
            case K_FGEMM: KON(K_FGEMM) { SchedGrid S; S.init(ws + O_WFT + (size_t)a0 * 2048 * 1024 * 2, ws + O_HBUF, 2048, a1, 1024);
                EpiFZ E{(bf16_t*)(ws + O_ZT), (bf16_t*)(ws + O_ZCT)}; gemm_phase(lds, 1024, 1024, 1024, S, E);
                if (DEFER && DEFER_HOOKS && rep == 0 && ph == 2 && get_bid() >= (S.nwg % (int)gridDim.x)) deferred_work(P, lds, 1, 3, 0); } break;
            case K_STEP1: KON(K_STEP1) { SchedGrid S; S.init(ws + O_FM1, ws + O_ZT, 256, 131072, 256);
                EpiStep1 E{(bf16_t*)(ws + O_YP), (const float2*)(ws + O_TW)}; gemm_phase(lds, 256, 256, 256, S, E); } break;
            case K_CTXDFT: KON(K_CTXDFT) { SchedGrid S2; S2.init(ws + O_FC, ws + O_ZCT, 256, 1024, 512);
                EpiCtxDft E2{xres, gc1}; gemm_phase(lds, 512, 512, 512, S2, E2); } break;
            case K_FOLD: KON(K_FOLD) { SchedFold S{(const char*)(ws + O_FWT), (const char*)(ws + O_TMAT)};
                EpiFold E{(bf16_t*)(ws + O_WFT)}; gemm_phase(lds, 256, 1024, 256, S, E); } break;
            case K_WOSPLIT: KON(K_WOSPLIT) { SchedSplit S; S.cnt = (const int*)(ws + O_CTL) + a0 * 8 * CSTR; S.moe = a1;
                if (a1) { int t = 0;
#pragma unroll
                    for (int e = 0; e < NEXP; ++e) t += (S.cnt[e * CSTR] + 255) >> 8;
                    S.tile0 = 128; S.ntile = t - 128; S.A = (const char*)(ws + O_HIDS); S.B = (const char*)(ws + O_MWO + (size_t)a0 * 8 * 1024 * 3584 * 2); S.estride = (size_t)1024 * 3584 * 2; }
                else { S.tile0 = 64; S.ntile = 1; S.A = (const char*)(ws + O_HID); S.B = (const char*)(ws + O_FWO); S.estride = 0; }
                EpiPartial E{(float*)(ws + O_YSP)}; gemm_phase(lds, KCH, DFF, DFF, S, E);
                if (DEFER && DEFER_HOOKS && rep == 0 && ph < 20 && get_bid() >= S.ntile * 4 * KSPL) deferred_work(P, lds, 1, 1, 0); } break;
            case K_STEP2: KON(K_STEP2) { SchedGrid S; S.init(ws + O_FM2, ws + O_YP, 256, 131072, 256);
                EpiStep2 E{xres, gx1, (ph == 4 && rep == 0) ? P.x : xres}; gemm_phase(lds, 256, 256, 256, S, E); } break;
            case K_FFNWI: KON(K_FFNWI) { SchedGrid S; S.init(ws + O_HBUF, ws + O_FWI + (size_t)a0 * 7168 * 1024 * 2, a1, 7168, 1024);
                EpiSwiglu E{(bf16_t*)(ws + O_HID)}; gemm_phase(lds, 1024, 1024, 1024, S, E);
                if (DEFER && DEFER_HOOKS && rep == 0 && ph == 6 && get_bid() >= (S.nwg % (int)gridDim.x)) deferred_work(P, lds, 1, 3, 0); } break;
            case K_FFNWO: KON(K_FFNWO) { SchedGrid S; S.init(ws + O_HID, ws + O_FWO + (size_t)a0 * 1024 * 3584 * 2, a1, 1024, 3584);
                const int nl = layer + 1;
                EpiResidNorm<false> E{xres, gx2, nullptr, P.norm_mix + nl * 1024, ada + (size_t)(nl * 2) * 6144, (bf16_t*)(ws + O_HBUF), (float*)(ws + O_PART),
                                      (unsigned*)(ws + O_ZERO + 4096) + (layer == 0 ? 0 : 1024), nl == 3 ? 1 : 0};
                gemm_phase(lds, 3584, 3584, 3584, S, E); } break;
            case K_QKV: KON(K_QKV) { SchedGrid S; EpiStoreBf16 E;
                if (a0 == 0) { S.init(ws + O_HBUF, ws + O_WQKV, MTOT, 1280, 1024); E.O = (bf16_t*)(ws + O_QK); E.ld = 1280; }
                else { S.init(ws + O_WQKV + (size_t)1280 * 1024 * 2, ws + O_HBUF, 256, MTOT, 1024); E.O = (bf16_t*)(ws + O_VT); E.ld = MTOT; S.boff = 128; }
                gemm_phase(lds, 1024, 1024, 1024, S, E);
                if (DEFER && DEFER_HOOKS && rep == 0 && a0 == 1) { const int b = get_bid(); if (b >= 69 && !(b >= 128 && b < 193)) deferred_work(P, lds, 1, 3, 0); } } break;
            case K_QKPOST: KON(K_QKPOST) qkpost_phase(P); break;
            case K_ATTN: KON(K_ATTN) attn_phase(P, lds); break;
            case K_ATTNWO: KON(K_ATTNWO) { SchedGrid S; S.init(ws + O_AO, ws + O_WO, SEQ, 1024, 1024);
                EpiResid E{xres, gx1, gc1}; gemm_phase(lds, 1024, 1024, 1024, S, E); } break;
            case K_GATHER: KON(K_GATHER) gather_phase(P, lds, a0); if (DEFER && rep == 0 && ph == 28) deferred_work(P, lds, 1 << 20, 8, TR_DEF); break;
            case K_MOEWI: KON(K_MOEWI) { SchedMoeT<true> S; S.inv = (const int*)(ws + O_INV); S.abase = (const char*)(ws + O_HBUF); S.init((const int*)(ws + O_CTL) + a0 * 8 * CSTR, ws + O_HBUF, ws + O_MWI + (size_t)a0 * 8 * 7168 * 1024 * 2, 7168, 1024, 0, 1 << 20);
                EpiSwiglu E{(bf16_t*)(ws + O_HIDS)}; gemm_phase(lds, 1024, 1024, 1024, S, E);
                if (DEFER && DEFER_HOOKS && rep == 0 && ph == 15) { const int rem = (S.T * S.nN) % (int)gridDim.x; if (rem != 0 && get_bid() >= rem) deferred_work(P, lds, 1, 3, 0); } } break;
            case K_MOEWO: KON(K_MOEWO) { SchedMoeT<false> S; S.init((const int*)(ws + O_CTL) + a0 * 8 * CSTR, ws + O_HIDS, ws + O_MWO + (size_t)a0 * 8 * 1024 * 3584 * 2, 1024, 3584, 1, MOE_SPLIT ? 128 : (1 << 20));
                EpiStoreBf16 E{(bf16_t*)(ws + O_YS), 1024}; gemm_phase(lds, 3584, 3584, 3584, S, E); } break;
            case K_POOL: KON(K_POOL) pool_phase(P); if (DEFER && rep == 0) deferred_work(P, lds, 1 << 20, 8, TR_DEF_DENSE); break;
            case K_POOLG: KON(K_POOLG) { SchedPool S{(const char*)(ws + O_POOL), (const char*)(ws + O_POOLW), (size_t)BM * 256 * 2};
                EpiResidNorm<true> E{xres, gx1, P.pool_scale, P.norm_ffn + layer * 1024, ada + (size_t)(layer * 2) * 6144 + 3 * 1024, (bf16_t*)(ws + O_HBUF), (float*)(ws + O_PART),
                                     (unsigned*)(ws + O_ZERO + 4096) + 2048, 0};
                gemm_phase(lds, 256, 256, 256, S, E); } break;
        }
      }
      }
        if (ph + 1 < P.ph_hi) { if (P.ph_hi > 4096) cg::this_grid().sync();
            xcd_barrier(xb); }
    }
}

extern "C" void kernel_launch(void* const* d_in, const int* in_sizes, int n_in, void* d_out, int out_size, void* d_ws, size_t ws_size, hipStream_t stream) {
    static int grid = 0;
    if (grid == 0) {
        if (n_in != 21 || ws_size < WS_END) { fprintf(stderr, "kernel_launch: need 21 inputs and %zu bytes of workspace, got %d / %zu\n", (size_t)WS_END, n_in, ws_size); grid = -1; return; }
        int dev = 0, cus = 0, per_cu = 0;
        (void)hipGetDevice(&dev); (void)hipDeviceGetAttribute(&cus, hipDeviceAttributeMultiprocessorCount, dev);
        if (hipFuncSetAttribute((const void*)mega_fwd, hipFuncAttributeMaxDynamicSharedMemorySize, LDS_ALLOC) != hipSuccess) { fprintf(stderr, "kernel_launch: hipFuncSetAttribute failed\n"); grid = -1; return; }
        if (hipOccupancyMaxActiveBlocksPerMultiprocessor(&per_cu, (const void*)mega_fwd, NTHR, LDS_ALLOC) != hipSuccess || per_cu < 1) { fprintf(stderr, "kernel_launch: occupancy query gives %d\n", per_cu); per_cu = 1; }
        (void)hipGetLastError();
        grid = cus;
        if (grid != 256) { fprintf(stderr, "kernel_launch: built for 256 CUs (fused residual+norm epilogues need one unit per workgroup), got %d\n", grid); grid = -1; return; }
    }
    if (grid < 0) return;
    if (hipMemsetAsync((char*)d_ws + O_BAR, 0, 32768, stream) != hipSuccess) { fprintf(stderr, "kernel_launch: memset failed\n"); return; }
    Params p{};
    const float** pp = (const float**)&p;
    for (int i = 0; i < 21; ++i) pp[i] = (const float*)d_in[i];
    p.out = (float*)d_out; p.ws = (unsigned char*)d_ws;
#if N_LAUNCH_MODE == 1
    p.ph_lo = 0; p.ph_hi = NPHASE;
    void* args[] = {&p};
    hipError_t e = hipLaunchCooperativeKernel((const void*)mega_fwd, dim3(grid), dim3(NTHR), args, LDS_ALLOC, stream);
    if (e != hipSuccess) fprintf(stderr, "cooperative launch failed: %s (grid %d)\n", hipGetErrorString(e), grid);
#else
    for (int ph = 0; ph < NPHASE; ++ph) { p.ph_lo = ph; p.ph_hi = ph + 1; hipLaunchKernelGGL(mega_fwd, dim3(grid), dim3(NTHR), LDS_ALLOC, stream, p); }
#endif
}
```

```cpp
#include <hip/hip_runtime.h>
#include <hip/hip_cooperative_groups.h>
#include <cstdio>
namespace cg = cooperative_groups;

#ifndef DEFER
#define DEFER 1
#endif
#ifndef DEFER_HOOKS
#define DEFER_HOOKS 1
#endif
#ifndef MOE_SPLIT
#define MOE_SPLIT 1
#endif
#ifndef N_LAUNCH_MODE
#define N_LAUNCH_MODE 1
#endif

#define LAS __attribute__((address_space(3)))
typedef unsigned short bf16_t;
typedef short bf16x8 __attribute__((ext_vector_type(8)));
typedef float f32x4 __attribute__((ext_vector_type(4)));
typedef float f32x16 __attribute__((ext_vector_type(16)));
typedef unsigned u32x4 __attribute__((ext_vector_type(4)));
typedef unsigned u32x2 __attribute__((ext_vector_type(2)));
typedef float f32x2 __attribute__((ext_vector_type(2)));

constexpr int D = 1024, SEQ = 16384, CTXL = 256, MTOT = SEQ + CTXL, DFF = 3584, NEXP = 8;
constexpr int NTHR = 512, NWAVE = 8;
constexpr int KSPL = 7, KCH = DFF / KSPL;
constexpr int LDS_BYTES = 131072, LDS_ALLOC = LDS_BYTES + 16;
constexpr int MOE_ROWS = 2 * SEQ + NEXP * 256;

constexpr size_t O_CTL   = 0;
constexpr int CSTR = 64;
constexpr size_t O_ADA   = 4096;
constexpr size_t O_TW    = O_ADA + 4 * 2 * 6 * 1024 * 4;
constexpr size_t O_ROPE  = O_TW + 16384 * 8;
constexpr size_t O_FM1   = O_ROPE + 256 * 16 * 8;
constexpr size_t O_FM2   = O_FM1 + 131072;
constexpr size_t O_FC    = O_FM2 + 131072;
constexpr size_t O_ROUTE = O_FC + 262144;
constexpr size_t O_RW    = O_ROUTE + 262144;
constexpr size_t O_WFT   = O_RW + 131072;
constexpr size_t O_WQKV  = O_WFT + (size_t)2 * 2048 * 1024 * 2;
constexpr size_t O_WO    = O_WQKV + (size_t)1536 * 1024 * 2;
constexpr size_t O_POOLW = O_WO + (size_t)1024 * 1024 * 2;
constexpr size_t O_FWI   = O_POOLW + (size_t)1024 * 256 * 2;
constexpr size_t O_FWO   = O_FWI + (size_t)2 * 7168 * 1024 * 2;
constexpr size_t O_MWI   = O_FWO + (size_t)2 * 1024 * 3584 * 2;
constexpr size_t O_MWO   = O_MWI + (size_t)16 * 7168 * 1024 * 2;
constexpr size_t O_XRES  = O_MWO + (size_t)16 * 1024 * 3584 * 2;
constexpr size_t O_HBUF  = O_XRES + (size_t)MTOT * 1024 * 4;
constexpr size_t O_ZT    = O_HBUF + (size_t)MTOT * 1024 * 2;
constexpr size_t O_ZCT   = O_ZT + (size_t)131072 * 256 * 2;
constexpr size_t O_YP    = O_ZCT + (size_t)1024 * 512 * 2;
constexpr size_t O_HID   = O_YP + (size_t)131072 * 256 * 2;
constexpr size_t O_QK    = O_HID + (size_t)MTOT * 3584 * 2;
constexpr size_t O_VT    = O_QK + (size_t)MTOT * 1280 * 2;
constexpr size_t O_AO    = O_VT + (size_t)256 * MTOT * 2;
constexpr size_t O_HS    = O_AO + (size_t)SEQ * 1024 * 2;
constexpr size_t O_HIDS  = O_HS + (size_t)MOE_ROWS * 1024 * 2;
constexpr size_t O_YS    = O_HIDS + (size_t)MOE_ROWS * 3584 * 2;
constexpr size_t O_POOL  = O_YS + (size_t)MOE_ROWS * 1024 * 4;
constexpr size_t O_BAR   = O_POOL + (size_t)65536 * 256 * 2;
constexpr size_t O_FWT   = O_BAR + 32768;
constexpr size_t O_TMAT  = O_FWT + (size_t)2 * 1024 * 1024 * 2;
constexpr size_t O_ZERO  = O_BAR + 16384;
constexpr size_t O_YSP   = O_TMAT + 512 * 256 * 2;
constexpr size_t O_BLK   = O_YSP + (size_t)KSPL * 2048 * 1024 * 4;
constexpr size_t O_SROW  = O_BLK + 1024 * 8 * 4;
constexpr size_t O_INV   = O_SROW + 16384 * 8;
constexpr size_t O_PART  = O_INV + (size_t)MOE_ROWS * 4;
constexpr size_t WS_END  = O_PART + 64 * 4 * 256 * 4;

struct Params {
    const float *x, *c, *ctx, *c_ctx, *ada_w, *ada_b, *norm_mix, *norm_ffn, *fnet_w, *wqkv, *q_gain, *k_gain, *sink, *attn_wo,
        *pool_w, *pool_scale, *ffn_wi, *ffn_wo, *router, *moe_wi, *moe_wo;
    float* out; unsigned char* ws; int ph_lo, ph_hi;
};

__device__ __forceinline__ unsigned pk2(float lo, float hi) { unsigned r; asm("v_cvt_pk_bf16_f32 %0, %1, %2" : "=v"(r) : "v"(lo), "v"(hi)); return r; }
__device__ __forceinline__ int get_tid() { int t = threadIdx.x; asm volatile("" : "+v"(t)); return t; }
__device__ __forceinline__ int get_bid() { int b = blockIdx.x; asm volatile("" : "+s"(b)); return b; }
__device__ __forceinline__ float bf2f(bf16_t b) { return __uint_as_float(((unsigned)b) << 16); }
__device__ __forceinline__ float bflo(unsigned u) { return __uint_as_float(u << 16); }
__device__ __forceinline__ float bfhi(unsigned u) { return __uint_as_float(u & 0xFFFF0000u); }
__device__ __forceinline__ float wave_sum(float v) {
#pragma unroll
    for (int o = 1; o < 64; o <<= 1) v += __shfl_xor(v, o);
    return v;
}
__device__ __forceinline__ int xcd_remap(int L, int nwg) { const int q = nwg >> 3, r = nwg & 7, xcd = L & 7, off = L >> 3; return (xcd < r ? xcd * (q + 1) : r * (q + 1) + (xcd - r) * q) + off; }
__device__ __forceinline__ float silu_f(float v) { return v * __builtin_amdgcn_rcpf(1.f + __expf(-v)); }


#define XB_TMO      128
#define XB_XCNT(j)  (256  + 64 * (j))
#define XB_XSUB(j)  (1280 + 64 * (j))
#define XB_XGEN(j)  (2304 + 64 * (j))
#define XB_TOP      3328
#define XB_TOPGEN   3392
#define XCD_BAR_WORDS 3456
#define XB_SPIN_CAP (1u << 18)
__device__ __forceinline__ unsigned xb_ld(unsigned* p)              { return __hip_atomic_load(p, __ATOMIC_RELAXED, __HIP_MEMORY_SCOPE_AGENT); }
__device__ __forceinline__ unsigned xb_add(unsigned* p, unsigned v) { return __hip_atomic_fetch_add(p, v, __ATOMIC_RELAXED, __HIP_MEMORY_SCOPE_AGENT); }
__device__ __forceinline__ unsigned xb_xcc_id() { return (unsigned)__builtin_amdgcn_s_getreg((3 << 11) | 20) & 0xFu; }
#define XB_SPIN(cond, bar) do { unsigned _sp = 0; while (cond) { __builtin_amdgcn_s_sleep(1); \
    if ((++_sp & 255u) == 0u) { if (xb_ld(&(bar)[XB_TMO])) break; if (_sp > XB_SPIN_CAP) { atomicAdd(&(bar)[XB_TMO], 1u); break; } } } } while (0)
struct XcdBarrier { unsigned* bar; unsigned x; volatile LAS unsigned* st; };
__device__ __forceinline__ XcdBarrier xcd_barrier_post(unsigned* bar, volatile LAS unsigned* st) {
    XcdBarrier b; b.bar = bar; b.x = xb_xcc_id(); b.st = st;
    if (threadIdx.x == 0) (void)xb_add(&bar[XB_XCNT(b.x)], 1u);
    return b;
}
__device__ __forceinline__ void xcd_barrier_complete(unsigned* bar, unsigned x, unsigned& nloc, unsigned& nx) {
    const unsigned G = gridDim.x * gridDim.y * gridDim.z;
    unsigned sum, cnt, mine, sp = 0u;
    for (;;) {
        sum = 0u; cnt = 0u; mine = 0u;
#pragma unroll
        for (unsigned j = 0; j < 16; ++j) { const unsigned c = xb_ld(&bar[XB_XCNT(j)]); sum += c; cnt += (c > 0u) ? 1u : 0u; mine = (j == x) ? c : mine; }
        if (sum == G) break;
        __builtin_amdgcn_s_sleep(1);
        if ((++sp & 255u) == 0u) { if (xb_ld(&bar[XB_TMO])) break; if (sp > XB_SPIN_CAP) { atomicAdd(&bar[XB_TMO], 1u); break; } }
    }
    nloc = mine > 0u ? mine : 1u; nx = cnt > 0u ? cnt : 1u;
}
__device__ __forceinline__ void xcd_barrier(const XcdBarrier& b) {
    asm volatile("s_waitcnt vmcnt(0)" ::: "memory");
    __syncthreads();
    if (threadIdx.x == 0) {
        unsigned* bar = b.bar;
        __builtin_amdgcn_s_waitcnt(0);
        unsigned nloc = b.st[0], nx = b.st[1];
        if (nloc == 0u) { xcd_barrier_complete(bar, b.x, nloc, nx); b.st[0] = nloc; b.st[1] = nx; }
        const unsigned old = xb_add(&bar[XB_XSUB(b.x)], 1u);
        const unsigned gen = old / nloc;
        if (old + 1u == (gen + 1u) * nloc) {
            __builtin_amdgcn_fence(__ATOMIC_RELEASE, "agent");
            asm volatile("s_waitcnt vmcnt(0)" ::: "memory");
            const unsigned og = xb_add(&bar[XB_TOP], 1u);
            const unsigned tg = og / nx;
            if (og + 1u == (tg + 1u) * nx) xb_add(&bar[XB_TOPGEN], 1u);
            else XB_SPIN(xb_ld(&bar[XB_TOPGEN]) == tg, bar);
            __builtin_amdgcn_fence(__ATOMIC_ACQUIRE, "agent");
            xb_add(&bar[XB_XGEN(b.x)], 1u);
            asm volatile("s_waitcnt vmcnt(0)" ::: "memory");
        } else {
            XB_SPIN(xb_ld(&bar[XB_XGEN(b.x)]) == gen, bar);
            __builtin_amdgcn_fence(__ATOMIC_ACQUIRE, "agent");
            asm volatile("s_waitcnt vmcnt(0)" ::: "memory");
        }
    }
    __syncthreads();
}

constexpr int BM = 256, BK = 64, HALF = 128, HTB = HALF * BK * 2, WGM = 8;
__device__ __forceinline__ int lds_byte(int r, int c) { const int st = (r >> 4) * 2 + (c >> 5), rr = r & 15, cc = c & 31, ob = rr * 64 + cc * 2; return st * 1024 + (ob ^ (((ob >> 9) & 1) << 5)); }
__device__ __forceinline__ void stage_rc(int b, int& R, int& C) { const int st = b / 1024, sb = b % 1024, swz = sb ^ (((sb >> 9) & 1) << 5); R = (st >> 1) * 16 + swz / 64; C = (st & 1) * 32 + (swz % 64) / 2; }
__device__ __forceinline__ int perm32(int rho) { const int n = rho >> 4, i = rho & 15; return 8 * (i >> 2) + 4 * n + (i & 3); }

struct Unit { int pm, pn; const char* a; const char* b; };

struct SchedGrid {   static constexpr bool GATHER = false;
    int nM, nN, nwg, boff = 0; const char* A; const char* B; size_t tstep;
    __device__ __forceinline__ void init(const void* A_, const void* B_, int M, int N, int K) { nM = M / BM; nN = N / BM; nwg = nM * nN; A = (const char*)A_; B = (const char*)B_; tstep = (size_t)BM * K * 2; }
    __device__ __forceinline__ bool next(int i, Unit& u) const {
        const int G = (int)gridDim.x; int vb = get_bid() + boff; vb = vb >= G ? vb - G : vb;
        const int L = i * G + vb; if (L >= nwg) return false;
        const int wgid = xcd_remap(L, nwg);
        const int nig = WGM * nN, gid = wgid / nig, fm = gid * WGM, gsz = (nM - fm) < WGM ? (nM - fm) : WGM;
        u.pm = fm + ((wgid % nig) % gsz); u.pn = (wgid % nig) / gsz;
        u.a = A + (size_t)u.pm * tstep; u.b = B + (size_t)u.pn * tstep; return true;
    }
};
struct SchedPool {   static constexpr bool GATHER = false;
    const char* A; const char* B; size_t tstep;
    __device__ __forceinline__ bool next(int i, Unit& u) const {
        const int L = i * (int)gridDim.x + get_bid(); if (L >= 256) return false;
        const int wgid = xcd_remap(L, 256);
        u.pm = wgid; u.pn = wgid >> 6; u.a = A + (size_t)u.pm * tstep; u.b = B + (size_t)u.pn * tstep; return true;
    }
};
struct SchedFold {   static constexpr bool GATHER = false;
    const char* A; const char* B;
    __device__ __forceinline__ bool next(int i, Unit& u) const {
        const int L = i * (int)gridDim.x + get_bid(); if (L >= 64) return false;
        const int c = L & 1, pm = (L >> 1) & 3, g = (L >> 3) & 3, j = L >> 5;
        u.pm = ((j * 4 + g) << 2) + pm; u.pn = c;
        u.a = A + ((size_t)j * 1024 * 1024 + (size_t)pm * 256 * 1024 + g * 256) * 2; u.b = B + (size_t)c * 256 * 256 * 2; return true;
    }
};
struct SchedSplit {   static constexpr bool GATHER = false;
    const int* cnt; int tile0, ntile, moe; const char* A; const char* B; size_t estride;
    __device__ __forceinline__ bool next(int i, Unit& u) const {
        const int L = i * (int)gridDim.x + get_bid(); if (L >= ntile * 4 * KSPL) return false;
        const int t = L / (4 * KSPL), rem = L % (4 * KSPL), ks = rem >> 2, pn = rem & 3, pm = tile0 + t;
        int es = 0;
        if (moe) { int a2 = 0;
#pragma unroll
            for (int e = 0; e < NEXP; ++e) { const int tt = (cnt[e * CSTR] + 255) >> 8; if (pm >= a2 && pm < a2 + tt) es = e; a2 += tt; } }
        u.pm = t; u.pn = pn * KSPL + ks;
        u.a = A + ((size_t)pm * 256 * DFF + ks * KCH) * 2; u.b = B + (size_t)es * estride + ((size_t)pn * 256 * DFF + ks * KCH) * 2; return true;
    }
};
template <bool GATHER_> struct SchedMoeT {    static constexpr bool GATHER = GATHER_; const int* inv = nullptr; const char* abase = nullptr;
    const int* cnt; int nN, T, rowmajor; const char* A; const char* B; size_t tstep, estride; int tl[NEXP];
    __device__ __forceinline__ void init(const int* cnt_, const void* A_, const void* B_, int N, int K, int rowmajor_, int maxT) {
        rowmajor = rowmajor_;
        cnt = cnt_; nN = N / BM; A = (const char*)A_; B = (const char*)B_; tstep = (size_t)BM * K * 2; estride = (size_t)N * K * 2;
        int t = 0;
#pragma unroll
        for (int e = 0; e < NEXP; ++e) { tl[e] = __builtin_amdgcn_readfirstlane((cnt[e * CSTR] + 255) >> 8); t += tl[e]; }
        T = t < maxT ? t : maxT;
    }
    __device__ __forceinline__ bool next(int i, Unit& u) const {
        const int nwg = T * nN; const int L = i * (int)gridDim.x + get_bid(); if (L >= nwg) return false;
        const int wgid = xcd_remap(L, nwg);
        int acc = 0, es = 0, ts = 0, te = 1;
#pragma unroll
        for (int e = 0; e < NEXP; ++e) { const int t = tl[e]; if (wgid >= acc * nN && wgid < (acc + t) * nN) { es = e; ts = acc; te = t; } acc += t; }
        const int r = wgid - ts * nN; u.pm = ts + r % te; u.pn = r / te;
        if (rowmajor) { u.pm = wgid / nN; u.pn = wgid % nN; int a2 = 0;
#pragma unroll
            for (int e = 0; e < NEXP; ++e) { const int t = tl[e]; if (u.pm >= a2 && u.pm < a2 + t) es = e; a2 += t; } }
        u.a = A + (size_t)u.pm * tstep; u.b = B + (size_t)es * estride + (size_t)u.pn * tstep; return true;
    }
};

template <class Epi, class Sched>
__device__ __forceinline__ void gemm_phase(LAS unsigned char* lds, const int K, const int lda, const int ldb, const Sched& S, const Epi& E) {
    const int tid = get_tid(), wid = __builtin_amdgcn_readfirstlane(tid >> 6), lane = tid & 63, wr = wid >> 2, wc = wid & 3, fr = lane & 15, fq = lane >> 4;
    const int nt = K / BK;
    constexpr bool GATHER = Sched::GATHER;
    unsigned voffA[2], voffB[2];
#pragma unroll
    for (int i = 0; i < 2; ++i) { int R, C; stage_rc(tid * 16 + i * 8192, R, C); const int Rb = Epi::PERM ? ((R & ~31) + perm32(R & 31)) : R;
        voffA[i] = (unsigned)(R * lda + C) * 2u; voffB[i] = (unsigned)(Rb * ldb + C) * 2u; }
    unsigned vcur[2][2] = {{0u, 0u}, {0u, 0u}}, vnxt[2][2] = {{0u, 0u}, {0u, 0u}}; int ix1[2][2] = {{0, 0}, {0, 0}};
    const int* invp = nullptr; if constexpr (GATHER) invp = S.inv;
    auto ld_ix = [&](int pm, int (&ix)[2][2]) {
#pragma unroll
        for (int i = 0; i < 2; ++i) { int R, C; stage_rc(get_tid() * 16 + i * 8192, R, C);
#pragma unroll
            for (int h = 0; h < 2; ++h) ix[h][i] = invp[pm * BM + h * HALF + R]; } };
    auto mk_off = [&](const int (&ix)[2][2], unsigned (&vo)[2][2]) {
#pragma unroll
        for (int i = 0; i < 2; ++i) { int R, C; stage_rc(get_tid() * 16 + i * 8192, R, C);
#pragma unroll
            for (int h = 0; h < 2; ++h) vo[h][i] = (unsigned)ix[h][i] * (unsigned)(lda * 2) + (unsigned)C * 2u; } };
    const size_t kstep = (size_t)(BK * 2);
    const size_t hstepA = (size_t)HALF * lda * 2, hstepB = (size_t)HALF * ldb * 2;
    const unsigned ldsw = (unsigned)wid * 1024u;
    const int aoff = lds_byte(wr * 64 + fr, fq * 8), boff = lds_byte(wc * 32 + fr, fq * 8);
#define PG8_SA(b, h) (((b) * 2 + (h)) * HTB)
#define PG8_SB(b, h) ((4 + (b) * 2 + (h)) * HTB)
#define PG8_STAGE(bufoff, gbase, voff) do { _Pragma("unroll") for (int _i = 0; _i < 2; ++_i) \
        __builtin_amdgcn_global_load_lds((const unsigned*)((const char*)(gbase) + (voff)[_i]), (LAS unsigned*)(lds + (bufoff) + ldsw + _i * 8192), 16, 0, 0); } while (0)
#define PG8_STAGE_A(bufoff, gbase, h, vv) do { if constexpr (GATHER) { _Pragma("unroll") for (int _i = 0; _i < 2; ++_i) \
        __builtin_amdgcn_global_load_lds((const unsigned*)((const char*)(gbase) + (vv)[h][_i]), (LAS unsigned*)(lds + (bufoff) + ldsw + _i * 8192), 16, 0, 0); } \
        else { PG8_STAGE(bufoff, (gbase) + (h) * hstepA, voffA); } } while (0)
#define PG8_LDA(dst, b, h) do { _Pragma("unroll") for (int m = 0; m < 4; ++m) _Pragma("unroll") for (int k = 0; k < 2; ++k) dst[m][k] = *(const LAS bf16x8*)(lds + PG8_SA(b, h) + aoff + m * 2048 + k * 1024); } while (0)
#define PG8_LDB(dst, b, h) do { _Pragma("unroll") for (int n = 0; n < 2; ++n) _Pragma("unroll") for (int k = 0; k < 2; ++k) dst[n][k] = *(const LAS bf16x8*)(lds + PG8_SB(b, h) + boff + n * 2048 + k * 1024); } while (0)
#define PG8_MMA(ai, bj, At, Bt) do { __builtin_amdgcn_s_setprio(1); _Pragma("unroll") for (int m = 0; m < 4; ++m) _Pragma("unroll") for (int n = 0; n < 2; ++n) _Pragma("unroll") for (int k = 0; k < 2; ++k) \
        acc[ai][bj][m][n] = __builtin_amdgcn_mfma_f32_16x16x32_bf16(Bt[n][k], At[m][k], acc[ai][bj][m][n], 0, 0, 0); __builtin_amdgcn_s_setprio(0); } while (0)
#define PG8_WAIT_V(n) asm volatile("s_waitcnt vmcnt(" #n ")" ::: "memory")
#define PG8_WAIT_L(n) asm volatile("s_waitcnt lgkmcnt(" #n ")" ::: "memory")
#define PG8_BAR __builtin_amdgcn_s_barrier()
#define PG8_SCHED __builtin_amdgcn_sched_barrier(0)
    Unit cur, nxt; int ui = 0;
    if (!S.next(0, cur)) return;
    f32x4 acc[2][2][4][2];
#pragma unroll
    for (int a = 0; a < 2; ++a)
#pragma unroll
        for (int b = 0; b < 2; ++b)
#pragma unroll
            for (int m = 0; m < 4; ++m)
#pragma unroll
                for (int n = 0; n < 2; ++n) acc[a][b][m][n] = (f32x4){0.f, 0.f, 0.f, 0.f};
    bf16x8 At[4][2], B0[2][2], B1[2][2];
    const char* cA = cur.a; const char* cB = cur.b;
    bool has_n1 = false;
    if constexpr (GATHER) {
        cA = S.abase;
        { int ix0[2][2]; ld_ix(cur.pm, ix0); mk_off(ix0, vcur); }
        has_n1 = S.next(1, nxt);
        if (has_n1) ld_ix(nxt.pm, ix1);
        asm volatile("s_waitcnt vmcnt(0)" ::: "memory");
    }
    PG8_STAGE(PG8_SB(0, 0), cB, voffB); PG8_STAGE_A(PG8_SA(0, 0), cA, 0, vcur); PG8_STAGE(PG8_SB(0, 1), cB + hstepB, voffB); PG8_STAGE_A(PG8_SA(0, 1), cA, 1, vcur);
    if (wr == 1) PG8_BAR;
    PG8_WAIT_V(4); PG8_BAR;
    PG8_STAGE(PG8_SB(1, 0), cB + kstep, voffB); PG8_STAGE_A(PG8_SA(1, 0), cA + kstep, 0, vcur); PG8_STAGE(PG8_SB(1, 1), cB + hstepB + kstep, voffB);
    PG8_WAIT_V(6); PG8_BAR;
    for (;;) {
        const bool has_next = S.next(ui + 1, nxt);
        const char* nA = has_next ? nxt.a : cA; const char* nB = has_next ? nxt.b : cB;
        if constexpr (GATHER) {
            nA = cA;
            if (has_next) mk_off(ix1, vnxt);
            else {
#pragma unroll
                for (int h = 0; h < 2; ++h)
#pragma unroll
                    for (int i = 0; i < 2; ++i) vnxt[h][i] = vcur[h][i];
            }
        }
#pragma unroll 1
        for (int t = 0; t < nt; t += 2) {
            const bool last = (t == nt - 2);
            const char* a1 = cA + (size_t)(t + 1) * kstep;
            const char* a2 = last ? nA : cA + (size_t)(t + 2) * kstep; const char* b2 = last ? nB : cB + (size_t)(t + 2) * kstep;
            const char* a3 = a2 + kstep; const char* b3 = b2 + kstep;
            PG8_LDB(B0, 0, 0); PG8_SCHED; PG8_LDA(At, 0, 0); PG8_STAGE_A(PG8_SA(1, 1), a1, 1, vcur);
            if constexpr (GATHER) { if (last) {
#pragma unroll
                for (int h = 0; h < 2; ++h)
#pragma unroll
                    for (int i = 0; i < 2; ++i) vcur[h][i] = vnxt[h][i]; } }
            PG8_WAIT_L(8); PG8_BAR; PG8_WAIT_L(0); PG8_MMA(0, 0, At, B0); PG8_BAR; PG8_SCHED;
            PG8_LDB(B1, 0, 1); PG8_STAGE(PG8_SB(0, 0), b2, voffB);
            PG8_BAR; PG8_WAIT_L(0); PG8_MMA(0, 1, At, B1); PG8_BAR;
            PG8_LDA(At, 0, 1); PG8_STAGE_A(PG8_SA(0, 0), a2, 0, vcur);
            PG8_BAR; PG8_WAIT_L(0); PG8_MMA(1, 0, At, B0); PG8_BAR; PG8_SCHED;
            PG8_STAGE(PG8_SB(0, 1), b2 + hstepB, voffB);
            PG8_WAIT_V(6); PG8_BAR; PG8_MMA(1, 1, At, B1); PG8_BAR;
            PG8_LDB(B0, 1, 0); PG8_SCHED; PG8_LDA(At, 1, 0); PG8_STAGE_A(PG8_SA(0, 1), a2, 1, vcur);
            PG8_WAIT_L(8); PG8_BAR; PG8_WAIT_L(0); PG8_MMA(0, 0, At, B0); PG8_BAR; PG8_SCHED;
            PG8_LDB(B1, 1, 1); PG8_STAGE(PG8_SB(1, 0), b3, voffB);
            PG8_BAR; PG8_WAIT_L(0); PG8_MMA(0, 1, At, B1); PG8_BAR;
            PG8_LDA(At, 1, 1); PG8_STAGE_A(PG8_SA(1, 0), a3, 0, vcur);
            PG8_BAR; PG8_WAIT_L(0); PG8_MMA(1, 0, At, B0); PG8_BAR; PG8_SCHED;
            PG8_STAGE(PG8_SB(1, 1), b3 + hstepB, voffB);
            PG8_WAIT_V(6); PG8_BAR; PG8_MMA(1, 1, At, B1); PG8_BAR;
        }
        if constexpr (GATHER) { Unit n2; if (has_next && S.next(ui + 2, n2)) ld_ix(n2.pm, ix1); }
        if constexpr (!Epi::AFTER_DRAIN) E(acc, cur, wr, wc, fr, fq);
        if (!has_next) break;
#pragma unroll
        for (int a = 0; a < 2; ++a)
#pragma unroll
            for (int b = 0; b < 2; ++b)
#pragma unroll
                for (int m = 0; m < 4; ++m)
#pragma unroll
                    for (int n = 0; n < 2; ++n) acc[a][b][m][n] = (f32x4){0.f, 0.f, 0.f, 0.f};
        cur = nxt; cA = nA; cB = nB; ++ui;

    }
    PG8_WAIT_V(0);
    if (wr == 0) PG8_BAR;
    PG8_BAR;
    if constexpr (Epi::AFTER_DRAIN) E.fused(acc, cur, wr, wc, fr, fq, lds);
#undef PG8_SA
#undef PG8_SB
#undef PG8_STAGE
#undef PG8_STAGE_A
#undef PG8_LDA
#undef PG8_LDB
#undef PG8_MMA
#undef PG8_WAIT_V
#undef PG8_WAIT_L
#undef PG8_BAR
#undef PG8_SCHED
}

typedef f32x4 Acc[2][2][4][2];

struct EpiStoreBf16 {
    static constexpr bool PERM = true, AFTER_DRAIN = false; bf16_t* O; size_t ld;
    __device__ __forceinline__ void operator()(const Acc& acc, const Unit& u, int wr, int wc, int fr, int fq) const {
        const int row0 = u.pm * BM + wr * 64 + fr, col0 = u.pn * BM + wc * 32 + 8 * fq;
#pragma unroll
        for (int ai = 0; ai < 2; ++ai)
#pragma unroll
            for (int m = 0; m < 4; ++m) { bf16_t* rp = O + (size_t)(row0 + ai * HALF + m * 16) * ld + col0;
#pragma unroll
                for (int bj = 0; bj < 2; ++bj) { const f32x4 v0 = acc[ai][bj][m][0], v1 = acc[ai][bj][m][1];
                    u32x4 o; o.x = pk2(v0[0], v0[1]); o.y = pk2(v0[2], v0[3]); o.z = pk2(v1[0], v1[1]); o.w = pk2(v1[2], v1[3]);
                    *(u32x4*)(rp + bj * HALF) = o; } }
    }
};
struct EpiFold {
    static constexpr bool PERM = true, AFTER_DRAIN = false; bf16_t* W;
    __device__ __forceinline__ void operator()(const Acc& acc, const Unit& u, int wr, int wc, int fr, int fq) const {
        const int pm = u.pm & 3, jg = u.pm >> 2, j = jg >> 2, g = jg & 3;
        const int row0 = pm * BM + wr * 64 + fr, col0 = wc * 32 + 8 * fq;
        bf16_t* base = W + ((size_t)j * 2048 + (size_t)u.pn * 1024) * 1024 + g * 256;
#pragma unroll
        for (int ai = 0; ai < 2; ++ai)
#pragma unroll
            for (int m = 0; m < 4; ++m) { bf16_t* rp = base + (size_t)(row0 + ai * HALF + m * 16) * 1024 + col0;
#pragma unroll
                for (int bj = 0; bj < 2; ++bj) { const f32x4 v0 = acc[ai][bj][m][0], v1 = acc[ai][bj][m][1];
                    u32x4 o; o.x = pk2(v0[0], v0[1]); o.y = pk2(v0[2], v0[3]); o.z = pk2(v1[0], v1[1]); o.w = pk2(v1[2], v1[3]);
                    *(u32x4*)(rp + bj * HALF) = o; } }
    }
};
struct EpiPartial {
    static constexpr bool PERM = false, AFTER_DRAIN = false; float* Yp;
    __device__ __forceinline__ void operator()(const Acc& acc, const Unit& u, int wr, int wc, int fr, int fq) const {
        const int ks = u.pn % KSPL, pn = u.pn / KSPL;
        const int row0 = u.pm * BM + wr * 64 + fr, col0 = pn * BM + wc * 32 + 4 * fq;
        float* base = Yp + (size_t)ks * 2048 * D;
#pragma unroll
        for (int ai = 0; ai < 2; ++ai)
#pragma unroll
            for (int m = 0; m < 4; ++m) { float* rp = base + (size_t)(row0 + ai * HALF + m * 16) * D + col0;
#pragma unroll
                for (int bj = 0; bj < 2; ++bj)
#pragma unroll
                    for (int n = 0; n < 2; ++n) *(f32x4*)(rp + bj * HALF + n * 16) = acc[ai][bj][m][n]; }
    }
};
struct EpiStoreF32 {
    static constexpr bool PERM = false, AFTER_DRAIN = false; float* C; size_t ld;
    __device__ __forceinline__ void operator()(const Acc& acc, const Unit& u, int wr, int wc, int fr, int fq) const {
        const int row0 = u.pm * BM + wr * 64 + fr, col0 = u.pn * BM + wc * 32 + 4 * fq;
#pragma unroll
        for (int ai = 0; ai < 2; ++ai)
#pragma unroll
            for (int m = 0; m < 4; ++m) { float* rp = C + (size_t)(row0 + ai * HALF + m * 16) * ld + col0;
#pragma unroll
                for (int bj = 0; bj < 2; ++bj)
#pragma unroll
                    for (int n = 0; n < 2; ++n) *(f32x4*)(rp + bj * HALF + n * 16) = acc[ai][bj][m][n]; }
    }
};
struct EpiResid {
    static constexpr bool PERM = false, AFTER_DRAIN = false; float* X; const float* gate_x; const float* gate_c;
    __device__ __forceinline__ void operator()(const Acc& acc, const Unit& u, int wr, int wc, int fr, int fq) const {
        const int row0 = u.pm * BM + wr * 64 + fr, col0 = u.pn * BM + wc * 32 + 4 * fq;
        const float* gp = (u.pm < SEQ / BM) ? gate_x : gate_c;
        f32x4 gv[2][2];
#pragma unroll
        for (int bj = 0; bj < 2; ++bj)
#pragma unroll
            for (int n = 0; n < 2; ++n) gv[bj][n] = *(const f32x4*)(gp + col0 + bj * HALF + n * 16);
#pragma unroll
        for (int ai = 0; ai < 2; ++ai)
#pragma unroll
            for (int m = 0; m < 4; ++m) { float* rp = X + (size_t)(row0 + ai * HALF + m * 16) * D + col0;
#pragma unroll
                for (int bj = 0; bj < 2; ++bj)
#pragma unroll
                    for (int n = 0; n < 2; ++n) { f32x4* p = (f32x4*)(rp + bj * HALF + n * 16); *p = *p + gv[bj][n] * acc[ai][bj][m][n]; } }
    }
};
template <bool POOL> struct EpiResidNorm {
    static constexpr bool PERM = false, AFTER_DRAIN = true;
    float* X; const float* gate; const float* scale; const float* gain; const float* adap  ; bf16_t* H; float* part; unsigned* cnt; int permute;
    __device__ __forceinline__ void operator()(const Acc&, const Unit&, int, int, int, int) const {}
    __device__ __forceinline__ void fused(Acc& acc, const Unit& u, int wr, int wc, int fr, int fq, LAS unsigned char* lds) const {
        const int tid = get_tid();
        const int owner = POOL ? u.pn : u.pn, panel = POOL ? (u.pm - 64 * u.pn) : u.pm;
        const int row0 = panel * BM + wr * 64 + fr, col0 = u.pn * BM + wc * 32 + 4 * fq;
        LAS float* psum = (LAS float*)lds; LAS float* rs = (LAS float*)(lds + 4096);
#pragma unroll
        for (int bj = 0; bj < 2; ++bj)
#pragma unroll
            for (int n = 0; n < 2; ++n) { const int col = col0 + bj * HALF + n * 16;
                f32x4 gv = *(const f32x4*)(gate + col); if (POOL) gv = gv * *(const f32x4*)(scale + col);
#pragma unroll
                for (int ai = 0; ai < 2; ++ai)
#pragma unroll
                    for (int m = 0; m < 4; ++m) { f32x4* p = (f32x4*)(X + (size_t)(row0 + ai * HALF + m * 16) * D + col); const f32x4 xv = *p + gv * acc[ai][bj][m][n]; *p = xv; acc[ai][bj][m][n] = xv; }
                __builtin_amdgcn_sched_barrier(0); }
#pragma unroll
        for (int ai = 0; ai < 2; ++ai)
#pragma unroll
            for (int m = 0; m < 4; ++m) { float sq = 0.f;
#pragma unroll
                for (int bj = 0; bj < 2; ++bj)
#pragma unroll
                    for (int n = 0; n < 2; ++n) { const f32x4 v = acc[ai][bj][m][n]; sq += (v[0] * v[0] + v[1] * v[1]) + (v[2] * v[2] + v[3] * v[3]); }
                sq += __shfl_xor(sq, 16); sq += __shfl_xor(sq, 32);
                if (fq == 0) psum[wc * 256 + ai * HALF + wr * 64 + m * 16 + fr] = sq; }
        __syncthreads();
        if (tid < 256) __hip_atomic_store(part + (size_t)(panel * 4 + owner) * 256 + tid, (psum[tid] + psum[256 + tid]) + (psum[512 + tid] + psum[768 + tid]), __ATOMIC_RELAXED, __HIP_MEMORY_SCOPE_AGENT);
        asm volatile("s_waitcnt vmcnt(0)" ::: "memory");
        __syncthreads();
        if (tid == 0) { unsigned* c = cnt + panel * 16; __hip_atomic_fetch_add(c, 1u, __ATOMIC_RELAXED, __HIP_MEMORY_SCOPE_AGENT);
            unsigned sp = 0; while (__hip_atomic_load(c, __ATOMIC_RELAXED, __HIP_MEMORY_SCOPE_AGENT) < 4u) { __builtin_amdgcn_s_sleep(1); if (++sp > (1u << 22)) break; } }
        __syncthreads();
        if (tid < 256) { float* pp = part + (size_t)panel * 4 * 256 + tid;
            const float p0 = __hip_atomic_load(pp, __ATOMIC_RELAXED, __HIP_MEMORY_SCOPE_AGENT), p1 = __hip_atomic_load(pp + 256, __ATOMIC_RELAXED, __HIP_MEMORY_SCOPE_AGENT),
                        p2 = __hip_atomic_load(pp + 512, __ATOMIC_RELAXED, __HIP_MEMORY_SCOPE_AGENT), p3 = __hip_atomic_load(pp + 768, __ATOMIC_RELAXED, __HIP_MEMORY_SCOPE_AGENT);
            rs[tid] = rsqrtf(((p0 + p1) + (p2 + p3)) * (1.f / D) + 1e-6f); }
        __syncthreads();
#pragma unroll
        for (int bj = 0; bj < 2; ++bj)
#pragma unroll
            for (int n = 0; n < 2; ++n) { const int col = col0 + bj * HALF + n * 16;
                const f32x4 ga = *(const f32x4*)(gain + col) * (1.f + *(const f32x4*)(adap + 1024 + col)), sh = *(const f32x4*)(adap + col);
#pragma unroll
                for (int ai = 0; ai < 2; ++ai)
#pragma unroll
                    for (int m = 0; m < 4; ++m) { const int rt = ai * HALF + wr * 64 + m * 16 + fr, row = panel * BM + rt; const float r = rs[rt];
                        const f32x4 hv = acc[ai][bj][m][n] * r * ga + sh;
                        const int orow = permute ? (128 * (row & 127) + (row >> 7)) : row;
                        u32x2 o; o.x = pk2(hv[0], hv[1]); o.y = pk2(hv[2], hv[3]); *(u32x2*)(H + (size_t)orow * D + col) = o; }
                __builtin_amdgcn_sched_barrier(0); }
        __syncthreads();
    }
};
struct EpiSwiglu {
    static constexpr bool PERM = true, AFTER_DRAIN = false; bf16_t* Hd;
    __device__ __forceinline__ void operator()(const Acc& acc, const Unit& u, int wr, int wc, int fr, int fq) const {
        const int row0 = u.pm * BM + wr * 64 + fr, col0 = u.pn * HALF + wc * 32 + 8 * fq;
#pragma unroll
        for (int ai = 0; ai < 2; ++ai)
#pragma unroll
            for (int m = 0; m < 4; ++m) { bf16_t* rp = Hd + (size_t)(row0 + ai * HALF + m * 16) * DFF + col0;
                float h[8];
#pragma unroll
                for (int n = 0; n < 2; ++n)
#pragma unroll
                    for (int e = 0; e < 4; ++e) { const float g = acc[ai][0][m][n][e], up = acc[ai][1][m][n][e]; h[4 * n + e] = silu_f(g) * up; }
                u32x4 o; o.x = pk2(h[0], h[1]); o.y = pk2(h[2], h[3]); o.z = pk2(h[4], h[5]); o.w = pk2(h[6], h[7]);
                *(u32x4*)rp = o; }
    }
};
struct EpiFZ {
    static constexpr bool PERM = true, AFTER_DRAIN = false; bf16_t* Zt; bf16_t* ZcT;
    __device__ __forceinline__ void operator()(const Acc& acc, const Unit& u, int wr, int wc, int fr, int fq) const {
        const int row0 = u.pm * BM + wr * 64 + fr, col0 = u.pn * BM + wc * 32 + 8 * fq;
#pragma unroll
        for (int ai = 0; ai < 2; ++ai)
#pragma unroll
            for (int m = 0; m < 4; ++m) { const int np = row0 + ai * HALF + m * 16, c = np >> 10, n = np & 1023;
#pragma unroll
                for (int bj = 0; bj < 2; ++bj) { const int j = col0 + bj * HALF; const f32x4 v0 = acc[ai][bj][m][0], v1 = acc[ai][bj][m][1];
                    u32x4 o; o.x = pk2(v0[0], v0[1]); o.y = pk2(v0[2], v0[3]); o.z = pk2(v1[0], v1[1]); o.w = pk2(v1[2], v1[3]);
                    bf16_t* dst;
                    if (u.pn < SEQ / BM) { const int l1 = j >> 7, l2 = j & 127; dst = Zt + ((size_t)(n * 128 + l1) * 2 + c) * 128 + l2; }
                    else { const int l = j - SEQ; dst = ZcT + (size_t)(n * 2 + c) * 256 + l; }
                    *(u32x4*)dst = o; } }
    }
};
struct EpiStep1 {
    static constexpr bool PERM = true, AFTER_DRAIN = false; bf16_t* Yp; const float2* tw;
    __device__ __forceinline__ void operator()(const Acc& acc, const Unit& u, int wr, int wc, int fr, int fq) const {
        const int col0 = u.pn * BM + wc * 32 + 8 * fq;
#pragma unroll
        for (int m = 0; m < 4; ++m) { const int ka = wr * 64 + m * 16 + fr; const float2 st = tw[ka]; const float2 t0 = tw[ka * (col0 & 127)];
#pragma unroll
            for (int bj = 0; bj < 2; ++bj) { const int q = col0 + bj * HALF, n = q >> 7, l1 = q & 127;
                bf16_t* dst = Yp + ((size_t)(ka * 1024 + n) * 2) * 128 + l1;
                float2 t = t0;
#pragma unroll
                for (int nn = 0; nn < 2; ++nn) {
                    float yr[4], yi[4];
#pragma unroll
                    for (int e = 0; e < 4; ++e) { const float a = acc[0][bj][m][nn][e], b = acc[1][bj][m][nn][e];
                        yr[e] = a * t.x + b * t.y; yi[e] = b * t.x - a * t.y;
                        const float tx = t.x * st.x - t.y * st.y, ty = t.x * st.y + t.y * st.x; t.x = tx; t.y = ty; }
                    u32x2 o; o.x = pk2(yr[0], yr[1]); o.y = pk2(yr[2], yr[3]);
                    u32x2 p; p.x = pk2(yi[0], yi[1]); p.y = pk2(yi[2], yi[3]);
                    *(u32x2*)(dst + 4 * nn) = o; *(u32x2*)(dst + 128 + 4 * nn) = p; }
                __builtin_amdgcn_sched_barrier(0); } }
    }
};
struct EpiStep2 {
    static constexpr bool PERM = false, AFTER_DRAIN = false; float* X; const float* gate; const float* Xin;
    __device__ __forceinline__ void operator()(const Acc& acc, const Unit& u, int wr, int wc, int fr, int fq) const {
        const int col0 = u.pn * BM + wc * 32 + 4 * fq;
#pragma unroll
        for (int m = 0; m < 4; ++m) { const int kb = wr * 64 + m * 16 + fr;
#pragma unroll
            for (int bj = 0; bj < 2; ++bj)
#pragma unroll
                for (int n = 0; n < 2; ++n) { const int q = col0 + bj * HALF + n * 16, ka = q >> 10, nn = q & 1023;
                    const f32x4 g = *(const f32x4*)(gate + nn) * (1.f / 2048.f);
                    const size_t o = (size_t)(ka + 128 * kb) * D + nn; *(f32x4*)(X + o) = *(const f32x4*)(Xin + o) + g * acc[0][bj][m][n]; }
            if (m & 1) __builtin_amdgcn_sched_barrier(0); }
    }
};
struct EpiCtxDft {
    static constexpr bool PERM = false, AFTER_DRAIN = false; float* X; const float* gate;
    __device__ __forceinline__ void operator()(const Acc& acc, const Unit& u, int wr, int wc, int fr, int fq) const {
        const int row0 = wr * 64 + fr, col0 = u.pn * BM + wc * 32 + 4 * fq;
#pragma unroll
        for (int bj = 0; bj < 2; ++bj)
#pragma unroll
            for (int n = 0; n < 2; ++n) { const int col = col0 + bj * HALF + n * 16;
                const f32x4 g = *(const f32x4*)(gate + col) * (1.f / 256.f);
#pragma unroll
                for (int ai = 0; ai < 2; ++ai)
#pragma unroll
                    for (int m = 0; m < 4; ++m) { f32x4* p = (f32x4*)(X + (size_t)(SEQ + row0 + ai * HALF + m * 16) * D + col); *p = *p + g * acc[ai][bj][m][n]; }
                __builtin_amdgcn_sched_barrier(0); }
    }
};
struct EpiPool {
    static constexpr bool PERM = false, AFTER_DRAIN = false; float* X; const float* gate; const float* scale;
    __device__ __forceinline__ void operator()(const Acc& acc, const Unit& u, int wr, int wc, int fr, int fq) const {
        const int g = u.pn, row0 = (u.pm - 64 * g) * BM + wr * 64 + fr, col0 = g * BM + wc * 32 + 4 * fq;
#pragma unroll
        for (int bj = 0; bj < 2; ++bj)
#pragma unroll
            for (int n = 0; n < 2; ++n) { const int col = col0 + bj * HALF + n * 16;
                const f32x4 gv = *(const f32x4*)(gate + col) * *(const f32x4*)(scale + col);
#pragma unroll
                for (int ai = 0; ai < 2; ++ai)
#pragma unroll
                    for (int m = 0; m < 4; ++m) { f32x4* p = (f32x4*)(X + (size_t)(row0 + ai * HALF + m * 16) * D + col); *p = *p + gv * acc[ai][bj][m][n]; }
                __builtin_amdgcn_sched_barrier(0); }
    }
};

__device__ __forceinline__ void transpose_item(const float* W, int K, int N, bf16_t* WT, int mode, LAS float* scr, int item, int lane) {
    const int nblk = N / 32, kb = item / nblk, nb = item % nblk, k0 = 64 * kb, n0 = 32 * nb;
#pragma unroll 8
    for (int i = 0; i < 32; ++i) { const int kk = 2 * i + (lane >> 5); scr[kk * 33 + (lane & 31)] = W[(size_t)(k0 + kk) * N + n0 + (lane & 31)]; }
    asm volatile("s_waitcnt lgkmcnt(0)" ::: "memory");
    int r0 = n0;
    if (mode == 1) { const int half = n0 / DFF, t = n0 % DFF; r0 = (t / 128) * 256 + half * 128 + (t % 128); }
    const int c = lane & 7;
#pragma unroll
    for (int j = 0; j < 4; ++j) { const int n = (lane >> 3) + 8 * j; const LAS float* s = scr + (8 * c) * 33 + n;
        u32x4 o; o.x = pk2(s[0 * 33], s[1 * 33]); o.y = pk2(s[2 * 33], s[3 * 33]); o.z = pk2(s[4 * 33], s[5 * 33]); o.w = pk2(s[6 * 33], s[7 * 33]);
        *(u32x4*)(WT + (size_t)(r0 + n) * K + k0 + 8 * c) = o; }
    asm volatile("s_waitcnt lgkmcnt(0)" ::: "memory");
}

struct TDesc { const float* src; bf16_t* dst; int K, N; };
constexpr int TR_WI = 16 * 224, TR_WO = 56 * 32, TR_QKV = 16 * 48, TR_AO = 16 * 32, TR_PW = 4 * 8, TR_FW = 16 * 32;
constexpr int TR_NIT = 8 * TR_WI + 8 * TR_WO + TR_WI + TR_WO + TR_QKV + TR_AO + 2 * TR_FW + 4 * TR_PW;
constexpr int TR_DEF_DENSE = TR_WI + TR_WO, TR_DEF = TR_DEF_DENSE + 8 * TR_WI + 8 * TR_WO, DCH = 8;
__device__ __forceinline__ TDesc tr_mk(const float* W, int K, int N, bf16_t* WT, int mode, int item) {
    const int nblk = N / 32, kb = item / nblk, nb = item % nblk, k0 = 64 * kb, n0 = 32 * nb;
    int r0 = n0;
    if (mode == 1) { const int half = n0 / DFF, t = n0 % DFF; r0 = (t / 128) * 256 + half * 128 + (t % 128); }
    TDesc d; d.src = W + (size_t)k0 * N + n0; d.dst = WT + (size_t)r0 * K + k0; d.K = K; d.N = N; return d;
}
__device__ __forceinline__ TDesc tr_decode(const Params& P, unsigned char* ws, int it, int deferred) {
    int r = it;
    if (deferred) {
        if (r < TR_WI) return tr_mk(P.ffn_wi + (size_t)1024 * 7168, 1024, 7168, (bf16_t*)(ws + O_FWI) + (size_t)7168 * 1024, 1, r); r -= TR_WI;
        if (r < TR_WO) return tr_mk(P.ffn_wo + (size_t)3584 * 1024, 3584, 1024, (bf16_t*)(ws + O_FWO) + (size_t)1024 * 3584, 0, r); r -= TR_WO;
        if (r < 8 * TR_WI) { const int e = 8 + r / TR_WI; return tr_mk(P.moe_wi + (size_t)e * 1024 * 7168, 1024, 7168, (bf16_t*)(ws + O_MWI) + (size_t)e * 7168 * 1024, 1, r % TR_WI); } r -= 8 * TR_WI;
        { const int e = 8 + r / TR_WO; return tr_mk(P.moe_wo + (size_t)e * 3584 * 1024, 3584, 1024, (bf16_t*)(ws + O_MWO) + (size_t)e * 1024 * 3584, 0, r % TR_WO); }
    }
    if (r < 8 * TR_WI) { const int e = r / TR_WI; return tr_mk(P.moe_wi + (size_t)e * 1024 * 7168, 1024, 7168, (bf16_t*)(ws + O_MWI) + (size_t)e * 7168 * 1024, 1, r % TR_WI); } r -= 8 * TR_WI;
    if (r < 8 * TR_WO) { const int e = r / TR_WO; return tr_mk(P.moe_wo + (size_t)e * 3584 * 1024, 3584, 1024, (bf16_t*)(ws + O_MWO) + (size_t)e * 1024 * 3584, 0, r % TR_WO); } r -= 8 * TR_WO;
    if (r < TR_WI) return tr_mk(P.ffn_wi, 1024, 7168, (bf16_t*)(ws + O_FWI), 1, r); r -= TR_WI;
    if (r < TR_WO) return tr_mk(P.ffn_wo, 3584, 1024, (bf16_t*)(ws + O_FWO), 0, r); r -= TR_WO;
    if (r < TR_QKV) return tr_mk(P.wqkv, 1024, 1536, (bf16_t*)(ws + O_WQKV), 0, r); r -= TR_QKV;
    if (r < TR_AO) return tr_mk(P.attn_wo, 1024, 1024, (bf16_t*)(ws + O_WO), 0, r); r -= TR_AO;
    if (r < 2 * TR_FW) { const int j = r / TR_FW; return tr_mk(P.fnet_w + (size_t)j * 1024 * 1024, 1024, 1024, (bf16_t*)(ws + O_FWT) + (size_t)j * 1024 * 1024, 0, r % TR_FW); } r -= 2 * TR_FW;
    const int g = r / TR_PW; return tr_mk(P.pool_w + (size_t)g * 65536, 256, 256, (bf16_t*)(ws + O_POOLW) + (size_t)g * 65536, 0, r % TR_PW);
}
__device__ __forceinline__ void tr_load(const TDesc& d, float (&v)[32], int lane) {
    const float* p = d.src + (size_t)(lane >> 5) * d.N + (lane & 31);
#pragma unroll
    for (int i = 0; i < 32; ++i) v[i] = __builtin_nontemporal_load(p + (size_t)(2 * i) * d.N);
}
__device__ __forceinline__ void tr_store(const TDesc& d, const float (&v)[32], LAS float* scr, int lane) {
#pragma unroll
    for (int i = 0; i < 32; ++i) scr[(2 * i + (lane >> 5)) * 33 + (lane & 31)] = v[i];
    asm volatile("s_waitcnt lgkmcnt(0)" ::: "memory");
    const int c = lane & 7;
#pragma unroll
    for (int j = 0; j < 4; ++j) { const int n = (lane >> 3) + 8 * j; const LAS float* s = scr + (8 * c) * 33 + n;
        u32x4 o; o.x = pk2(s[0 * 33], s[1 * 33]); o.y = pk2(s[2 * 33], s[3 * 33]); o.z = pk2(s[4 * 33], s[5 * 33]); o.w = pk2(s[6 * 33], s[7 * 33]);
        *(u32x4*)(d.dst + (size_t)n * d.K + 8 * c) = o; }
    asm volatile("s_waitcnt lgkmcnt(0)" ::: "memory");
}

__device__ __forceinline__ void prep_phase(const Params& P, LAS unsigned char* lds) {
    const int tid = get_tid(), wave = tid >> 6, lane = tid & 63;
    unsigned char* ws = P.ws;
    const int gtid = get_bid() * NTHR + tid, gthreads = gridDim.x * NTHR;
    if (gtid < 16) ((int*)(ws + O_CTL))[gtid * CSTR] = 0;
    for (int t = gtid; t < 16384; t += gthreads) { float s, c; sincospif((float)t * (1.f / 8192.f), &s, &c); ((float2*)(ws + O_TW))[t] = make_float2(c, s); }
    for (int t = gtid; t < 256 * 16; t += gthreads) { const int pos = t >> 4, i = t & 15; const float inv = powf(10000.f, -(float)(2 * i) / 32.f); float s, c; sincosf((float)pos * inv, &s, &c); ((float2*)(ws + O_ROPE))[t] = make_float2(c, s); }
    for (int t = gtid; t < 256 * 256; t += gthreads) {
        const int r = t >> 8, cc = t & 255, cp = r >> 7, k = r & 127, c = cc >> 7, l = cc & 127; float s, co; sincospif((float)((k * l) & 127) * (1.f / 64.f), &s, &co);
        const float v1 = (cp == c) ? co : (cp == 0 ? s : -s);
        ((bf16_t*)(ws + O_FM1))[t] = (bf16_t)(pk2(v1, 0.f) & 0xFFFF);
        const float v2 = (cp == 0) ? (c == 0 ? co : s) : 0.f;
        ((bf16_t*)(ws + O_FM2))[t] = (bf16_t)(pk2(v2, 0.f) & 0xFFFF);
    }
    for (int t = gtid; t < 256 * 512; t += gthreads) {
        const int k = t >> 9, cc = t & 511, c = cc >> 8, l = cc & 255; float s, co; sincospif((float)((k * l) & 255) * (1.f / 128.f), &s, &co);
        ((bf16_t*)(ws + O_FC))[t] = (bf16_t)(pk2(c == 0 ? co : s, 0.f) & 0xFFFF);
    }
    for (int t = gtid; t < 512 * 256; t += gthreads) {
        const int r = t >> 8, mp = t & 255, c = r >> 8, ch = r & 255; float sn, co; sincospif((float)((ch * mp) & 255) * (1.f / 128.f), &sn, &co);
        ((bf16_t*)(ws + O_TMAT))[t] = (bf16_t)(pk2(c == 0 ? co : -sn, 0.f) & 0xFFFF);
    }
    { const f32x4* cs = (const f32x4*)P.ctx; f32x4* xd = (f32x4*)(ws + O_XRES);
      for (int t = gtid; t < CTXL * 256; t += gthreads) xd[SEQ * 256 + t] = cs[t]; }
    {
        LAS float* sc = (LAS float*)lds;
        LAS float* red = (LAS float*)(lds + 8192);
        for (int t = tid; t < 1024; t += NTHR) { sc[t] = silu_f(P.c[t]); sc[1024 + t] = silu_f(P.c_ctx[t]); }
        __syncthreads();
        for (int it = get_bid(); it < 192; it += gridDim.x) {
            const int i = it / 48, q = it % 48, col = 128 * q + 2 * lane;
            const float* wp = P.ada_w + (size_t)i * 1024 * 6144 + col;
            f32x2 a0 = {0, 0}, a1 = {0, 0};
#pragma unroll 16
            for (int kk = 0; kk < 128; ++kk) { const int k = wave * 128 + kk; const f32x2 w = *(const f32x2*)(wp + (size_t)k * 6144); a0 += sc[k] * w; a1 += sc[1024 + k] * w; }
            LAS float* rp = red + (wave * 64 + lane) * 4;
            rp[0] = a0[0]; rp[1] = a0[1]; rp[2] = a1[0]; rp[3] = a1[1];
            __syncthreads();
            if (wave == 0) {
                float s[4] = {0.f, 0.f, 0.f, 0.f};
#pragma unroll
                for (int w = 0; w < 8; ++w)
#pragma unroll
                    for (int e = 0; e < 4; ++e) s[e] += red[(w * 64 + lane) * 4 + e];
                const f32x2 bb = *(const f32x2*)(P.ada_b + i * 6144 + col);
                float* o0 = (float*)(ws + O_ADA) + (size_t)(i * 2 + 0) * 6144 + col; float* o1 = (float*)(ws + O_ADA) + (size_t)(i * 2 + 1) * 6144 + col;
                *(f32x2*)o0 = (f32x2){s[0] + bb[0], s[1] + bb[1]};
                *(f32x2*)o1 = (f32x2){s[2] + bb[0], s[3] + bb[1]};
            }
            __syncthreads();
        }
    }
    __syncthreads();
    {
        LAS float* scr = (LAS float*)(lds + wave * 8448);
        const int gw = get_bid() * NWAVE + wave, ngw = gridDim.x * NWAVE;
        int it = gw;
        float v[32]; TDesc cur;
        if (it < TR_NIT) { cur = tr_decode(P, ws, it, 0); tr_load(cur, v, lane); }
        while (it < TR_NIT) {
            const int nit = it + ngw; float w[32]; TDesc nx = cur;
            if (nit < TR_NIT) { nx = tr_decode(P, ws, nit, 0); tr_load(nx, w, lane); }
            tr_store(cur, v, scr, lane);
#pragma unroll
            for (int i = 0; i < 32; ++i) v[i] = w[i];
            cur = nx; it = nit;
        }
    }
}

__device__ __forceinline__ void deferred_work(const Params& P, LAS unsigned char* lds, int maxclaims, int units, int limit_items) {
    const int tid = get_tid(), wave = tid >> 6, lane = tid & 63;
    unsigned char* ws = P.ws;
    LAS float* scr = (LAS float*)(lds + wave * 8448); volatile LAS int* sc = (volatile LAS int*)(lds + 8 * 8448);
    unsigned* ctr = (unsigned*)(ws + O_BAR) + 3600;
    for (int n = 0; n < maxclaims; ++n) {
        __syncthreads();
        if (tid == 0) { int c = -1; const unsigned cur = __hip_atomic_load(ctr, __ATOMIC_RELAXED, __HIP_MEMORY_SCOPE_AGENT);
            const int stop = limit_items > 0 ? limit_items : TR_DEF;
            if ((int)cur * DCH < stop) c = (int)atomicAdd(ctr, (unsigned)units);
            *sc = c; }
        __syncthreads();
        const int c = *sc, base = c * DCH;
        if (c < 0 || base >= TR_DEF) break;
        const int cend = base + units * DCH, i1 = cend < TR_DEF ? cend : TR_DEF;
        int it = base + wave;
        float v[32]; TDesc cur;
        if (it < i1) { cur = tr_decode(P, ws, it, 1); tr_load(cur, v, lane); }
        while (it < i1) {
            const int nit = it + NWAVE; float w[32]; TDesc nx = cur;
            if (nit < i1) { nx = tr_decode(P, ws, nit, 1); tr_load(nx, w, lane); }
            tr_store(cur, v, scr, lane);
#pragma unroll
            for (int i = 0; i < 32; ++i) v[i] = w[i];
            cur = nx; it = nit;
        }
    }
    __syncthreads();
}

__device__ __forceinline__ void norm_phase(const Params& P, LAS unsigned char* lds, int layer, int which, int nrows, int flags, int fprev, int fnext, const float* g2ovr, const float* xsrc, const float* gcp) {
    const int tid = get_tid(), wave = tid >> 6, lane = tid & 63;
    unsigned char* ws = P.ws;
    float* xres = (float*)(ws + O_XRES);
    bf16_t* hbuf = (bf16_t*)(ws + O_HBUF);
    const float* ada = (const float*)(ws + O_ADA);
    const int gw = get_bid() * NWAVE + wave, ngw = gridDim.x * NWAVE;
    LAS float* rt = (LAS float*)lds;
    LAS int* etab = (LAS int*)(lds + 49152);
    LAS int* rtab = (LAS int*)(lds + 49152 + 8192);
    if (flags & 2) { const float* rp = P.router + (size_t)fnext * 1024 * 8;
        for (int t = tid; t < 1024; t += NTHR) { const int qq = t >> 6, ln = t & 63, col = 4 * ln + 256 * (qq >> 2) + (qq & 3);
            const f32x4 a = *(const f32x4*)(rp + col * 8), b = *(const f32x4*)(rp + col * 8 + 4); LAS f32x4* d = (LAS f32x4*)(rt + (qq * 64 + ln) * 12); d[0] = a; d[1] = b; }
        for (int t = tid; t < 2048; t += NTHR) etab[t] = -1; __syncthreads(); }
    const float* g2p = nullptr;
    if (flags & 4) {
        g2p = g2ovr ? g2ovr : ada + (size_t)((layer - 1) * 2 + 0) * 6144 + 5 * 1024;
    }
    const float2* rw = (const float2*)(ws + O_RW);
    const bf16_t* ysb = (const bf16_t*)(ws + O_YS); const float* ysp = (const float*)(ws + O_YSP);
    auto ldy = [&](int rowi, int j, int thr) -> f32x4 {
        if (rowi < thr) { const u32x2 raw = *((const u32x2*)(ysb + (size_t)rowi * D + 256 * j) + lane); return (f32x4){bflo(raw.x), bfhi(raw.x), bflo(raw.y), bfhi(raw.y)}; }
        f32x4 t[KSPL];
#pragma unroll
        for (int ks = 0; ks < KSPL; ++ks) t[ks] = *((const f32x4*)(ysp + ((size_t)ks * 2048 + (rowi - 32768)) * D + 256 * j) + lane);
        f32x4 a = t[0];
#pragma unroll
        for (int ks = 1; ks < KSPL; ++ks) a += t[ks];
        return a; };
    for (int pass = 0; pass < 2; ++pass) {
        const int rlo = pass == 0 ? 0 : SEQ, rhi = pass == 0 ? (nrows < SEQ ? nrows : SEQ) : nrows;
        if (rlo >= rhi || (pass == 0 && (flags & 32))) continue;
        f32x4 ga[4], sh[4], g2[4];
        if (!(flags & 8)) {
            const float* gain = (which == 0 ? P.norm_mix : P.norm_ffn) + layer * 1024;
            const float* ap = ada + (size_t)(layer * 2 + pass) * 6144 + (which == 0 ? 0 : 3 * 1024);
#pragma unroll
            for (int j = 0; j < 4; ++j) { const int col = 4 * lane + 256 * j; ga[j] = *(const f32x4*)(gain + col) * (1.f + *(const f32x4*)(ap + 1024 + col)); sh[j] = *(const f32x4*)(ap + col); }
        }
        if (flags & 4) {
#pragma unroll
            for (int j = 0; j < 4; ++j) g2[j] = *(const f32x4*)(g2p + 4 * lane + 256 * j);
        }
        int2 nsr = make_int2(0, 0); float2 nw = make_float2(0.f, 0.f);
        if ((flags & 4) && rlo + gw < rhi) { nsr = ((const int2*)(ws + O_SROW))[rlo + gw]; nw = rw[rlo + gw]; }
        for (int r = rlo + gw; r < rhi; r += ngw) {
            f32x4 v[4];
            const f32x4* xr = (const f32x4*)((r < SEQ ? xsrc : xres) + (size_t)r * D) + lane;
#pragma unroll
            for (int j = 0; j < 4; ++j) v[j] = xr[64 * j];
            if (flags & 4) {
                const int2 sr = nsr; const float2 w = nw;
                if (r + ngw < rhi) { nsr = ((const int2*)(ws + O_SROW))[r + ngw]; nw = rw[r + ngw]; }
                const int r0 = sr.x, r1 = sr.y;
#pragma unroll
                for (int j = 0; j < 4; ++j) v[j] = v[j] + g2[j] * (w.x * ldy(r0, j, MOE_SPLIT ? 32768 : (1 << 30)) + w.y * ldy(r1, j, MOE_SPLIT ? 32768 : (1 << 30)));
                f32x4* xo = (f32x4*)(((flags & 8) ? P.out : xres) + (size_t)r * D) + lane;
#pragma unroll
                for (int j = 0; j < 4; ++j) xo[64 * j] = v[j];
            }
            if ((flags & 16) && r >= SEQ) {
#pragma unroll
                for (int j = 0; j < 4; ++j) v[j] = v[j] + *(const f32x4*)(gcp + 4 * lane + 256 * j) * ldy(32768 + r - SEQ, j, 32768);
                f32x4* xo = (f32x4*)(xres + (size_t)r * D) + lane;
#pragma unroll
                for (int j = 0; j < 4; ++j) xo[64 * j] = v[j];
            }
            if (flags & 8) continue;
            float ss = 0.f;
#pragma unroll
            for (int j = 0; j < 4; ++j) ss += (v[j][0] * v[j][0] + v[j][1] * v[j][1]) + (v[j][2] * v[j][2] + v[j][3] * v[j][3]);
            const float rstd = rsqrtf(wave_sum(ss) * (1.f / D) + 1e-6f);
#pragma unroll
            for (int j = 0; j < 4; ++j) v[j] = v[j] * rstd * ga[j] + sh[j];
            int orow = r;
            if ((flags & 1) && r < SEQ) orow = 128 * (r & 127) + (r >> 7);
            u32x2* o8 = (u32x2*)(hbuf + (size_t)orow * D) + lane;
#pragma unroll
            for (int j = 0; j < 4; ++j) { u32x2 o; o.x = pk2(v[j][0], v[j][1]); o.y = pk2(v[j][2], v[j][3]); o8[64 * j] = o; }
            if (flags & 2) {
                float lg[8];
#pragma unroll
                for (int e = 0; e < 8; ++e) lg[e] = 0.f;
#pragma unroll
                for (int j = 0; j < 4; ++j)
#pragma unroll
                    for (int e = 0; e < 4; ++e) { const LAS f32x4* rr = (const LAS f32x4*)(rt + ((j * 4 + e) * 64 + lane) * 12); const f32x4 r0 = rr[0], r1 = rr[1]; const float hv = v[j][e];
                        lg[0] += hv * r0[0]; lg[1] += hv * r0[1]; lg[2] += hv * r0[2]; lg[3] += hv * r0[3]; lg[4] += hv * r1[0]; lg[5] += hv * r1[1]; lg[6] += hv * r1[2]; lg[7] += hv * r1[3]; }
#pragma unroll
                for (int e = 0; e < 8; ++e) lg[e] = wave_sum(lg[e]);
                int e0 = 0; float v0 = lg[0];
#pragma unroll
                for (int e = 1; e < 8; ++e) if (lg[e] > v0) { v0 = lg[e]; e0 = e; }
                int e1 = -1; float v1 = -3.0e38f;
#pragma unroll
                for (int e = 0; e < 8; ++e) if (e != e0 && lg[e] > v1) { v1 = lg[e]; e1 = e; }
                if (lane == 0) {
                    const int rho = ((r - gw) / ngw) * NWAVE + wave;
                    etab[2 * rho] = e0; etab[2 * rho + 1] = e1;
                    const float ex = __expf(v1 - v0), w0 = 1.f / (1.f + ex);
                    ((float2*)(ws + O_RW))[r] = make_float2(w0, ex * w0);
                }
            }
        }
    }
    if (flags & 2) {
        __syncthreads();
        const int nent = 2 * NWAVE * ((SEQ + ngw - 1) / ngw);
        if (wave == 0) {
            int run[NEXP];
#pragma unroll
            for (int e = 0; e < NEXP; ++e) run[e] = 0;
            for (int base = 0; base < nent; base += 64) {
                const int i = base + lane, ee = etab[i]; int myrank = 0;
#pragma unroll
                for (int e = 0; e < NEXP; ++e) { const unsigned long long mask = __ballot(ee == e); if (ee == e) myrank = run[e] + __popcll(mask & ((1ull << lane) - 1ull)); run[e] += __popcll(mask); }
                rtab[i] = myrank;
            }
            int mine = 0;
#pragma unroll
            for (int e = 0; e < NEXP; ++e) if (lane == e) mine = run[e];
            if (lane < NEXP) ((int*)(ws + O_BLK))[get_bid() * NEXP + lane] = mine;
        }
        __syncthreads();
        if (lane == 0) {
            int4* route_w = (int4*)(ws + O_ROUTE);
            for (int r = gw; r < SEQ; r += ngw) { const int rho = ((r - gw) / ngw) * NWAVE + wave; route_w[r] = make_int4(etab[2 * rho], rtab[2 * rho], etab[2 * rho + 1], rtab[2 * rho + 1]); }
        }
        __syncthreads();
    }
}

__device__ __forceinline__ void gather_phase(const Params& P, LAS unsigned char* lds, int f) {
    const int tid = get_tid(), wave = tid >> 6, lane = tid & 63;
    unsigned char* ws = P.ws;
    const int gw = get_bid() * NWAVE + wave, ngw = gridDim.x * NWAVE, nb = gridDim.x;
    LAS int* pre = (LAS int*)lds;
    LAS int* tot = (LAS int*)(lds + 32768);
    const int* blk = (const int*)(ws + O_BLK);
    __syncthreads();
    for (int t = tid; t < nb * NEXP; t += NTHR) pre[t] = blk[t];
    __syncthreads();
    {
        const int e = wave; int c[4], sum = 0;
#pragma unroll
        for (int j = 0; j < 4; ++j) { const int b = 4 * lane + j; c[j] = (b < nb) ? pre[b * NEXP + e] : 0; sum += c[j]; }
        int incl = sum;
#pragma unroll
        for (int o = 1; o < 64; o <<= 1) { const int t = __shfl_up(incl, o); if (lane >= o) incl += t; }
        int run = incl - sum; const int total = __shfl(incl, 63);
#pragma unroll
        for (int j = 0; j < 4; ++j) { const int b = 4 * lane + j; if (b < nb) { pre[b * NEXP + e] = run; run += c[j]; } }
        if (lane == 0) { tot[e] = total; if (get_bid() == 0) ((int*)(ws + O_CTL))[(f * 8 + e) * CSTR] = total; }
    }
    __syncthreads();
    int off[NEXP], cn[NEXP]; { int a = 0;
#pragma unroll
        for (int e = 0; e < NEXP; ++e) { cn[e] = tot[e]; off[e] = a; a += ((cn[e] + 255) >> 8) << 8; } }
    const int4* route = (const int4*)(ws + O_ROUTE);
    int* inv = (int*)(ws + O_INV);
    for (int t = get_bid() * NTHR + tid; t < SEQ; t += nb * NTHR) {
        const int4 ro = route[t]; const int b = (t % ngw) / NWAVE;
        int r0 = pre[b * NEXP + ro.x] + ro.y, r1 = pre[b * NEXP + ro.z] + ro.w;
#pragma unroll
        for (int e = 0; e < NEXP; ++e) { if (ro.x == e) r0 += off[e]; if (ro.z == e) r1 += off[e]; }
        ((int2*)(ws + O_SROW))[t] = make_int2(r0, r1);
        inv[r0] = t; inv[r1] = t;
    }
#pragma unroll
    for (int e = 0; e < NEXP; ++e) {
        const int lo = off[e] + cn[e], hi = off[e] + (((cn[e] + 255) >> 8) << 8);
        for (int r = lo + get_bid() * NTHR + tid; r < hi; r += nb * NTHR) inv[r] = 0;
    }
    __syncthreads();
}

__device__ __forceinline__ void qkpost_phase(const Params& P) {
    const int tid = get_tid(), wave = tid >> 6, lane = tid & 63;
    unsigned char* ws = P.ws;
    const int gw = get_bid() * NWAVE + wave, ngw = gridDim.x * NWAVE;
    bf16_t* qk = (bf16_t*)(ws + O_QK); const float2* rope = (const float2*)(ws + O_ROPE);
    const int sub = lane & 15, d0 = 4 * sub;
    const f32x4 gq = *(const f32x4*)(P.q_gain + d0), gk = *(const f32x4*)(P.k_gain + d0);
    for (int r = gw; r < MTOT; r += ngw) {
        const int pos = (sub < 8) ? (r >> 6) : (r & 63);
        float2 cs[4];
#pragma unroll
        for (int e = 0; e < 4; ++e) cs[e] = rope[(pos & 255) * 16 + 4 * (sub & 3) + e];
#pragma unroll
        for (int p = 0; p < 5; ++p) {
            const int hh = 4 * p + (lane >> 4); const bool isq = hh < 16;
            u32x2* ptr = (u32x2*)(qk + (size_t)r * 1280 + hh * 64 + d0);
            const u32x2 raw = *ptr;
            float y[4] = {bflo(raw.x), bfhi(raw.x), bflo(raw.y), bfhi(raw.y)};
            float ss = (y[0] * y[0] + y[1] * y[1]) + (y[2] * y[2] + y[3] * y[3]);
            ss += __shfl_xor(ss, 1); ss += __shfl_xor(ss, 2); ss += __shfl_xor(ss, 4); ss += __shfl_xor(ss, 8);
            const float rs = rsqrtf(ss * (1.f / 64.f) + 1e-6f) * (isq ? 0.125f : 1.f);
            const f32x4 g = isq ? gq : gk;
#pragma unroll
            for (int e = 0; e < 4; ++e) y[e] = y[e] * rs * g[e];
            float py[4];
#pragma unroll
            for (int e = 0; e < 4; ++e) py[e] = __shfl_xor(y[e], 4);
            if (r < SEQ) {
#pragma unroll
                for (int e = 0; e < 4; ++e) y[e] = (sub & 4) ? (py[e] * cs[e].y + y[e] * cs[e].x) : (y[e] * cs[e].x - py[e] * cs[e].y);
            }
            if (r < SEQ || !isq) { u32x2 o; o.x = pk2(y[0], y[1]); o.y = pk2(y[2], y[3]); *ptr = o; }
        }
    }
}

__device__ __forceinline__ void attn_chunk(LAS unsigned char* Kl, LAS unsigned char* Vl, const bf16x8 (&qf)[4], f32x16 (&o)[2], float& m, float& l, int q, int half, int ii, int maskmode) {
    f32x16 s[2];
#pragma unroll
    for (int kb = 0; kb < 2; ++kb) {
#pragma unroll
        for (int r = 0; r < 16; ++r) s[kb][r] = 0.f;
#pragma unroll
        for (int ks = 0; ks < 4; ++ks) { const bf16x8 kf = *(const LAS bf16x8*)(Kl + (32 * kb + q) * 144 + (2 * ks + half) * 16); s[kb] = __builtin_amdgcn_mfma_f32_32x32x16_bf16(kf, qf[ks], s[kb], 0, 0, 0); }
    }
    if (maskmode != 0) {
#pragma unroll
        for (int kb = 0; kb < 2; ++kb)
#pragma unroll
            for (int r = 0; r < 16; ++r) { const int jj = 32 * kb + 8 * (r >> 2) + 4 * half + (r & 3); const bool ok = (maskmode == 1) ? (jj >= ii) : (jj <= ii); if (!ok) s[kb][r] = -1e30f; }
    }
    float mx = s[0][0];
#pragma unroll
    for (int kb = 0; kb < 2; ++kb)
#pragma unroll
        for (int r = 0; r < 16; ++r) mx = fmaxf(mx, s[kb][r]);
    mx = fmaxf(mx, __shfl_xor(mx, 32));
    const float mn = fmaxf(m, mx), alpha = __expf(m - mn);
    float ps = 0.f;
#pragma unroll
    for (int kb = 0; kb < 2; ++kb)
#pragma unroll
        for (int r = 0; r < 16; ++r) { const float p = __expf(s[kb][r] - mn); s[kb][r] = p; ps += p; }
    l = l * alpha + ps; m = mn;
#pragma unroll
    for (int db = 0; db < 2; ++db)
#pragma unroll
        for (int r = 0; r < 16; ++r) o[db][r] *= alpha;
#pragma unroll
    for (int kb = 0; kb < 2; ++kb)
#pragma unroll
        for (int t = 0; t < 2; ++t) {
            union { bf16x8 v; unsigned u[4]; } pf;
#pragma unroll
            for (int i = 0; i < 4; ++i) pf.u[i] = pk2(s[kb][8 * t + 2 * i], s[kb][8 * t + 2 * i + 1]);
#pragma unroll
            for (int db = 0; db < 2; ++db) {
                union { bf16x8 v; u32x2 h[2]; } vf;
                const LAS unsigned char* vp = Vl + (32 * db + q) * 136 + (32 * kb + 16 * t + 4 * half) * 2;
                vf.h[0] = *(const LAS u32x2*)vp; vf.h[1] = *(const LAS u32x2*)(vp + 16);
                o[db] = __builtin_amdgcn_mfma_f32_32x32x16_bf16(vf.v, pf.v, o[db], 0, 0, 0);
            }
        }
}
__device__ __forceinline__ void attn_stage(LAS unsigned char* Kl, LAS unsigned char* Vl, const bf16_t* qk, const bf16_t* Vt, int tok0, int g, int tid, const float* kgain, const float2* rope, bool do_rope) {
    const int row = tid >> 3, piece = tid & 7;
    const u32x4 kraw = *(const u32x4*)(qk + (size_t)(tok0 + row) * 1280 + 1024 + 64 * g + 8 * piece);
    float y[8] = {bflo(kraw.x), bfhi(kraw.x), bflo(kraw.y), bfhi(kraw.y), bflo(kraw.z), bfhi(kraw.z), bflo(kraw.w), bfhi(kraw.w)};
    float ss = 0.f;
#pragma unroll
    for (int i = 0; i < 8; ++i) ss += y[i] * y[i];
    ss += __shfl_xor(ss, 1); ss += __shfl_xor(ss, 2); ss += __shfl_xor(ss, 4);
    const float rs = rsqrtf(ss * (1.f / 64.f) + 1e-6f);
    const f32x4 g0 = *(const f32x4*)(kgain + 8 * piece), g1 = *(const f32x4*)(kgain + 8 * piece + 4);
#pragma unroll
    for (int i = 0; i < 4; ++i) { y[i] *= rs * g0[i]; y[4 + i] *= rs * g1[i]; }
    float py[8];
#pragma unroll
    for (int i = 0; i < 8; ++i) py[i] = __shfl_xor(y[i], 2);
    if (do_rope) {
        const int token = tok0 + row, pos = (piece < 4) ? (token >> 6) : (token & 63);
        const float2* cs = rope + pos * 16 + 8 * (piece & 1);
#pragma unroll
        for (int i = 0; i < 8; ++i) { const float2 t = cs[i]; y[i] = (piece & 2) ? (py[i] * t.y + y[i] * t.x) : (y[i] * t.x - py[i] * t.y); }
    }
    u32x4 kv; kv.x = pk2(y[0], y[1]); kv.y = pk2(y[2], y[3]); kv.z = pk2(y[4], y[5]); kv.w = pk2(y[6], y[7]);
    *(LAS u32x4*)(Kl + row * 144 + piece * 16) = kv;
    const u32x4 vv = *(const u32x4*)(Vt + (size_t)(g * 64 + row) * MTOT + tok0 + 8 * piece);
    LAS u32x2* vd = (LAS u32x2*)(Vl + row * 136 + piece * 16); vd[0] = (u32x2){vv.x, vv.y}; vd[1] = (u32x2){vv.z, vv.w};
}
__device__ __forceinline__ void attn_phase(const Params& P, LAS unsigned char* lds) {
    const int tid = get_tid(), wave = tid >> 6, lane = tid & 63, q = lane & 31, half = lane >> 5;
    unsigned char* ws = P.ws;
    const bf16_t* qk = (const bf16_t*)(ws + O_QK); const bf16_t* Vt = (const bf16_t*)(ws + O_VT); bf16_t* ao = (bf16_t*)(ws + O_AO);
    const float2* rope = (const float2*)(ws + O_ROPE);
    constexpr int KSZ = 64 * 144, VSZ = 64 * 136, VBASE = 5 * KSZ;
    for (int unit = get_bid(); unit < 1024; unit += gridDim.x) {
        const int qb = unit >> 2, g = unit & 3, h = 4 * g + (wave >> 1), ii = 32 * (wave & 1) + q, tok = 64 * qb + ii;
        bf16x8 qf[4];
        {
            float yq[4][8]; float ss = 0.f;
#pragma unroll
            for (int ks = 0; ks < 4; ++ks) { const u32x4 raw = *(const u32x4*)(qk + (size_t)tok * 1280 + h * 64 + 16 * ks + 8 * half);
                yq[ks][0] = bflo(raw.x); yq[ks][1] = bfhi(raw.x); yq[ks][2] = bflo(raw.y); yq[ks][3] = bfhi(raw.y); yq[ks][4] = bflo(raw.z); yq[ks][5] = bfhi(raw.z); yq[ks][6] = bflo(raw.w); yq[ks][7] = bfhi(raw.w);
#pragma unroll
                for (int i = 0; i < 8; ++i) ss += yq[ks][i] * yq[ks][i]; }
            ss += __shfl_xor(ss, 32);
            const float rs = rsqrtf(ss * (1.f / 64.f) + 1e-6f) * 0.125f;
#pragma unroll
            for (int ks = 0; ks < 4; ++ks) { const f32x4 g0 = *(const f32x4*)(P.q_gain + 16 * ks + 8 * half), g1 = *(const f32x4*)(P.q_gain + 16 * ks + 8 * half + 4);
#pragma unroll
                for (int i = 0; i < 4; ++i) { yq[ks][i] *= rs * g0[i]; yq[ks][4 + i] *= rs * g1[i]; } }
            const float2* cr = rope + (tok >> 6) * 16 + 8 * half; const float2* cc = rope + (tok & 63) * 16 + 8 * half;
#pragma unroll
            for (int i = 0; i < 8; ++i) { const float2 tr = cr[i], tc = cc[i];
                const float a1 = yq[0][i], a2 = yq[1][i]; yq[0][i] = a1 * tr.x - a2 * tr.y; yq[1][i] = a1 * tr.y + a2 * tr.x;
                const float b1 = yq[2][i], b2 = yq[3][i]; yq[2][i] = b1 * tc.x - b2 * tc.y; yq[3][i] = b1 * tc.y + b2 * tc.x; }
#pragma unroll
            for (int ks = 0; ks < 4; ++ks) { union { bf16x8 v; unsigned u[4]; } pk;
#pragma unroll
                for (int i = 0; i < 4; ++i) pk.u[i] = pk2(yq[ks][2 * i], yq[ks][2 * i + 1]);
                qf[ks] = pk.v; }
        }
        float m = P.sink[h], l = (half == 0) ? 1.f : 0.f;
        f32x16 o[2];
#pragma unroll
        for (int db = 0; db < 2; ++db)
#pragma unroll
            for (int r = 0; r < 16; ++r) o[db][r] = 0.f;
#pragma unroll
        for (int ci = 0; ci < 5; ++ci) { const int cb = qb - 2 + ci; if (cb >= 0 && cb < SEQ / 64) attn_stage(lds + ci * KSZ, lds + VBASE + ci * VSZ, qk, Vt, 64 * cb, g, tid, P.k_gain, rope, true); }
        __syncthreads();
#pragma unroll
        for (int ci = 0; ci < 5; ++ci) { const int cb = qb - 2 + ci; if (cb >= 0 && cb < SEQ / 64) attn_chunk(lds + ci * KSZ, lds + VBASE + ci * VSZ, qf, o, m, l, q, half, ii, ci == 0 ? 1 : (ci == 4 ? 2 : 0)); }
        __syncthreads();
#pragma unroll
        for (int ci = 0; ci < 4; ++ci) attn_stage(lds + ci * KSZ, lds + VBASE + ci * VSZ, qk, Vt, SEQ + 64 * ci, g, tid, P.k_gain, rope, false);
        __syncthreads();
#pragma unroll
        for (int ci = 0; ci < 4; ++ci) attn_chunk(lds + ci * KSZ, lds + VBASE + ci * VSZ, qf, o, m, l, q, half, ii, 0);
        __syncthreads();
        const float lt = l + __shfl_xor(l, 32), inv = 1.f / lt;
        bf16_t* op = ao + (size_t)tok * D + h * 64;
#pragma unroll
        for (int db = 0; db < 2; ++db)
#pragma unroll
            for (int rg = 0; rg < 4; ++rg) { u32x2 ov; ov.x = pk2(o[db][4 * rg] * inv, o[db][4 * rg + 1] * inv); ov.y = pk2(o[db][4 * rg + 2] * inv, o[db][4 * rg + 3] * inv);
                *(u32x2*)(op + 32 * db + 8 * rg + 4 * half) = ov; }
    }
}

__device__ __forceinline__ void pool_phase(const Params& P) {
    const int tid = get_tid(), wave = tid >> 6, lane = tid & 63;
    unsigned char* ws = P.ws;
    const int gw = get_bid() * NWAVE + wave, ngw = gridDim.x * NWAVE;
    const bf16_t* hbuf = (const bf16_t*)(ws + O_HBUF); bf16_t* pl = (bf16_t*)(ws + O_POOL);
    for (int t = gw; t < SEQ; t += ngw) {
#pragma unroll
        for (int j = 0; j < 4; ++j) {
            const int w = 2 << j; int lo = t - (w >> 1), hi = t + (w >> 1) - 1; lo = lo < 0 ? 0 : lo; hi = hi > SEQ - 1 ? SEQ - 1 : hi;
            float s[4] = {0.f, 0.f, 0.f, 0.f};
            for (int tt = lo; tt <= hi; ++tt) { const u32x2 raw = *((const u32x2*)(hbuf + (size_t)tt * D + 256 * j) + lane); s[0] += bflo(raw.x); s[1] += bfhi(raw.x); s[2] += bflo(raw.y); s[3] += bfhi(raw.y); }
            const u32x2 self = *((const u32x2*)(hbuf + (size_t)t * D + 256 * j) + lane);
            const float ic = 1.f / (float)(hi - lo + 1);
            u32x2 o; o.x = pk2(s[0] * ic - bflo(self.x), s[1] * ic - bfhi(self.x)); o.y = pk2(s[2] * ic - bflo(self.y), s[3] * ic - bfhi(self.y));
            *((u32x2*)(pl + ((size_t)j * SEQ + t) * 256) + lane) = o;
        }
    }
}

enum { K_PREP, K_NORM, K_FGEMM, K_STEP1, K_STEP2, K_FFNWI, K_FFNWO, K_QKV, K_QKPOST, K_ATTN, K_ATTNWO, K_GATHER, K_MOEWI, K_MOEWO, K_POOL, K_POOLG, K_CTXDFT, K_FOLD, K_WOSPLIT, K_NONE };
constexpr int NPHASE = 32;

__global__ void __launch_bounds__(NTHR, 2) mega_fwd(Params P) {
    extern __shared__ __attribute__((aligned(16))) unsigned char smem[];
    LAS unsigned char* lds = (LAS unsigned char*)smem;
    unsigned char* ws = P.ws;
    const float* ada = (const float*)(ws + O_ADA);
    float* xres = (float*)(ws + O_XRES);
    volatile LAS unsigned* xst = (volatile LAS unsigned*)(lds + LDS_BYTES);
    if (threadIdx.x == 0) { xst[0] = 0u; xst[1] = 0u; }
    __syncthreads();
    const XcdBarrier xb = xcd_barrier_post((unsigned*)(ws + O_BAR), xst);
#ifndef REPEAT_MASK
#define REPEAT_MASK 0u
#endif

    for (int ph = P.ph_lo; ph < P.ph_hi; ++ph) {
      if (ph == 10) continue;
      if (ph == 20 || ph == 23) continue;
      const int nrep = ((REPEAT_MASK >> ph) & 1u) ? 2 : 1;
      for (int rep = 0; rep < nrep; ++rep) {
      if (rep > 0) xcd_barrier(xb);
      for (int sub = 0; sub < 2; ++sub) {
        if (rep > 0 && sub > 0) continue;
        int kind = K_NONE, layer = 0, a0 = 0, a1 = 0, a2 = 0, a3 = 0;
        if (sub == 0) {
        switch (ph) {
            case 0: kind = K_PREP; break;
            case 1: kind = K_NORM; layer = 0; a0 = 0; a1 = MTOT; a2 = 1; break;
            case 2: kind = K_FGEMM; layer = 0; a0 = 0; a1 = MTOT; break;
            case 3: kind = K_STEP1; layer = 0; break;
            case 4: kind = K_STEP2; layer = 0; break;
            case 5: kind = K_NORM; layer = 0; a0 = 1; a1 = MTOT; break;
            case 6: kind = K_FFNWI; a0 = 0; a1 = MTOT; break;
            case 7: kind = K_FFNWO; layer = 0; a0 = 0; a1 = SEQ; break;
            case 8: kind = K_NORM; layer = 1; a0 = 0; a1 = MTOT; a2 = 16 | 32; break;
            case 9: kind = K_QKV; break;
            case 10: kind = K_QKPOST; break;
            case 11: kind = K_ATTN; break;
            case 12: kind = K_ATTNWO; layer = 1; break;
            case 13: kind = K_NORM; layer = 1; a0 = 1; a1 = SEQ; a2 = 2; a3 = 0; break;
            case 14: kind = K_GATHER; a0 = 0; break;
            case 15: kind = K_MOEWI; a0 = 0; break;
            case 16: kind = K_MOEWO; a0 = 0; break;
            case 17: kind = K_NORM; layer = 2; a0 = 0; a1 = SEQ; a2 = 4; a3 = 0; break;
            case 18: kind = K_POOL; break;
            case 19: kind = K_POOLG; layer = 2; break;
            case 20: kind = K_NORM; layer = 2; a0 = 1; a1 = SEQ; break;
            case 21: kind = K_FFNWI; a0 = 1; a1 = SEQ; break;
            case 22: kind = K_FFNWO; layer = 2; a0 = 1; a1 = SEQ; break;
            case 23: kind = K_NORM; layer = 3; a0 = 0; a1 = SEQ; a2 = 1; break;
            case 24: kind = K_FGEMM; layer = 3; a0 = 1; a1 = SEQ; break;
            case 25: kind = K_STEP1; layer = 3; break;
            case 26: kind = K_STEP2; layer = 3; break;
            case 27: kind = K_NORM; layer = 3; a0 = 1; a1 = SEQ; a2 = 2; a3 = 1; break;
            case 28: kind = K_GATHER; a0 = 1; break;
            case 29: kind = K_MOEWI; a0 = 1; break;
            case 30: kind = K_MOEWO; a0 = 1; break;
            default: kind = K_NORM; layer = 4; a0 = 0; a1 = SEQ; a2 = 4 | 8; a3 = 1; break;
        }
        } else {
            if (ph == 1) { kind = K_FOLD; }
            else if (ph == 3) { kind = K_CTXDFT; layer = 0; }
            else if (ph == 9) { kind = K_QKV; a0 = 1; }
            else if (ph == 7) { kind = K_WOSPLIT; a0 = 0; a1 = 0; }
            else if (MOE_SPLIT && ph == 16) { kind = K_WOSPLIT; a0 = 0; a1 = 1; }
            else if (MOE_SPLIT && ph == 30) { kind = K_WOSPLIT; a0 = 1; a1 = 1; }
        }
        if (kind == K_NONE) continue;
        const float* zv = (const float*)(ws + O_ZERO);
        const int lyr = layer < 4 ? layer : 3;
        const float* gx1 = rep > 0 ? zv : ada + (size_t)(lyr * 2) * 6144 + 2 * 1024;
        const float* gx2 = rep > 0 ? zv : ada + (size_t)(lyr * 2) * 6144 + 5 * 1024;
        const float* gc1 = rep > 0 ? zv : ada + (size_t)(lyr * 2 + 1) * 6144 + 2 * 1024;
        const float* gc2 = rep > 0 ? zv : ada + (size_t)(lyr * 2 + 1) * 6144 + 5 * 1024;
#ifndef KIND_MASK
#define KIND_MASK 0xFFFFFF
#endif
#define KON(k) if (!((KIND_MASK >> (k)) & 1)) break;
        switch (kind) {
            case K_PREP: KON(K_PREP) prep_phase(P, lds); break;
            case K_NORM: KON(K_NORM) norm_phase(P, lds, layer, a0, a1, a2, a3, a3, rep > 0 ? zv : nullptr, (ph == 1) ? P.x : xres, rep > 0 ? zv : ada + (size_t)(0 * 2 + 1) * 6144 + 5 * 1024);
                break;
            case K_FGEMM: KON(K_FGEMM) { SchedGrid S; S.init(ws + O_WFT + (size_t)a0 * 2048 * 1024 * 2, ws + O_HBUF, 2048, a1, 1024);
                EpiFZ E{(bf16_t*)(ws + O_ZT), (bf16_t*)(ws + O_ZCT)}; gemm_phase(lds, 1024, 1024, 1024, S, E);
                if (DEFER && DEFER_HOOKS && rep == 0 && ph == 2 && get_bid() >= (S.nwg % (int)gridDim.x)) deferred_work(P, lds, 1, 3, 0); } break;
            case K_STEP1: KON(K_STEP1) { SchedGrid S; S.init(ws + O_FM1, ws + O_ZT, 256, 131072, 256);
                EpiStep1 E{(bf16_t*)(ws + O_YP), (const float2*)(ws + O_TW)}; gemm_phase(lds, 256, 256, 256, S, E); } break;
            case K_CTXDFT: KON(K_CTXDFT) { SchedGrid S2; S2.init(ws + O_FC, ws + O_ZCT, 256, 1024, 512);
                EpiCtxDft E2{xres, gc1}; gemm_phase(lds, 512, 512, 512, S2, E2); } break;
            case K_FOLD: KON(K_FOLD) { SchedFold S{(const char*)(ws + O_FWT), (const char*)(ws + O_TMAT)};
                EpiFold E{(bf16_t*)(ws + O_WFT)}; gemm_phase(lds, 256, 1024, 256, S, E); } break;
            case K_WOSPLIT: KON(K_WOSPLIT) { SchedSplit S; S.cnt = (const int*)(ws + O_CTL) + a0 * 8 * CSTR; S.moe = a1;
                if (a1) { int t = 0;
#pragma unroll
                    for (int e = 0; e < NEXP; ++e) t += (S.cnt[e * CSTR] + 255) >> 8;
                    S.tile0 = 128; S.ntile = t - 128; S.A = (const char*)(ws + O_HIDS); S.B = (const char*)(ws + O_MWO + (size_t)a0 * 8 * 1024 * 3584 * 2); S.estride = (size_t)1024 * 3584 * 2; }
                else { S.tile0 = 64; S.ntile = 1; S.A = (const char*)(ws + O_HID); S.B = (const char*)(ws + O_FWO); S.estride = 0; }
                EpiPartial E{(float*)(ws + O_YSP)}; gemm_phase(lds, KCH, DFF, DFF, S, E);
                if (DEFER && DEFER_HOOKS && rep == 0 && ph < 20 && get_bid() >= S.ntile * 4 * KSPL) deferred_work(P, lds, 1, 1, 0); } break;
            case K_STEP2: KON(K_STEP2) { SchedGrid S; S.init(ws + O_FM2, ws + O_YP, 256, 131072, 256);
                EpiStep2 E{xres, gx1, (ph == 4 && rep == 0) ? P.x : xres}; gemm_phase(lds, 256, 256, 256, S, E); } break;
            case K_FFNWI: KON(K_FFNWI) { SchedGrid S; S.init(ws + O_HBUF, ws + O_FWI + (size_t)a0 * 7168 * 1024 * 2, a1, 7168, 1024);
                EpiSwiglu E{(bf16_t*)(ws + O_HID)}; gemm_phase(lds, 1024, 1024, 1024, S, E);
                if (DEFER && DEFER_HOOKS && rep == 0 && ph == 6 && get_bid() >= (S.nwg % (int)gridDim.x)) deferred_work(P, lds, 1, 3, 0); } break;
            case K_FFNWO: KON(K_FFNWO) { SchedGrid S; S.init(ws + O_HID, ws + O_FWO + (size_t)a0 * 1024 * 3584 * 2, a1, 1024, 3584);
                const int nl = layer + 1;
                EpiResidNorm<false> E{xres, gx2, nullptr, P.norm_mix + nl * 1024, ada + (size_t)(nl * 2) * 6144, (bf16_t*)(ws + O_HBUF), (float*)(ws + O_PART),
                                      (unsigned*)(ws + O_ZERO + 4096) + (layer == 0 ? 0 : 1024), nl == 3 ? 1 : 0};
                gemm_phase(lds, 3584, 3584, 3584, S, E); } break;
            case K_QKV: KON(K_QKV) { SchedGrid S; EpiStoreBf16 E;
                if (a0 == 0) { S.init(ws + O_HBUF, ws + O_WQKV, MTOT, 1280, 1024); E.O = (bf16_t*)(ws + O_QK); E.ld = 1280; }
                else { S.init(ws + O_WQKV + (size_t)1280 * 1024 * 2, ws + O_HBUF, 256, MTOT, 1024); E.O = (bf16_t*)(ws + O_VT); E.ld = MTOT; S.boff = 128; }
                gemm_phase(lds, 1024, 1024, 1024, S, E);
                if (DEFER && DEFER_HOOKS && rep == 0 && a0 == 1) { const int b = get_bid(); if (b >= 69 && !(b >= 128 && b < 193)) deferred_work(P, lds, 1, 3, 0); } } break;
            case K_QKPOST: KON(K_QKPOST) qkpost_phase(P); break;
            case K_ATTN: KON(K_ATTN) attn_phase(P, lds); break;
            case K_ATTNWO: KON(K_ATTNWO) { SchedGrid S; S.init(ws + O_AO, ws + O_WO, SEQ, 1024, 1024);
                EpiResid E{xres, gx1, gc1}; gemm_phase(lds, 1024, 1024, 1024, S, E); } break;
            case K_GATHER: KON(K_GATHER) gather_phase(P, lds, a0); if (DEFER && rep == 0 && ph == 28) deferred_work(P, lds, 1 << 20, 8, TR_DEF); break;
            case K_MOEWI: KON(K_MOEWI) { SchedMoeT<true> S; S.inv = (const int*)(ws + O_INV); S.abase = (const char*)(ws + O_HBUF); S.init((const int*)(ws + O_CTL) + a0 * 8 * CSTR, ws + O_HBUF, ws + O_MWI + (size_t)a0 * 8 * 7168 * 1024 * 2, 7168, 1024, 0, 1 << 20);
                EpiSwiglu E{(bf16_t*)(ws + O_HIDS)}; gemm_phase(lds, 1024, 1024, 1024, S, E);
                if (DEFER && DEFER_HOOKS && rep == 0 && ph == 15) { const int rem = (S.T * S.nN) % (int)gridDim.x; if (rem != 0 && get_bid() >= rem) deferred_work(P, lds, 1, 3, 0); } } break;
            case K_MOEWO: KON(K_MOEWO) { SchedMoeT<false> S; S.init((const int*)(ws + O_CTL) + a0 * 8 * CSTR, ws + O_HIDS, ws + O_MWO + (size_t)a0 * 8 * 1024 * 3584 * 2, 1024, 3584, 1, MOE_SPLIT ? 128 : (1 << 20));
                EpiStoreBf16 E{(bf16_t*)(ws + O_YS), 1024}; gemm_phase(lds, 3584, 3584, 3584, S, E); } break;
            case K_POOL: KON(K_POOL) pool_phase(P); if (DEFER && rep == 0) deferred_work(P, lds, 1 << 20, 8, TR_DEF_DENSE); break;
            case K_POOLG: KON(K_POOLG) { SchedPool S{(const char*)(ws + O_POOL), (const char*)(ws + O_POOLW), (size_t)BM * 256 * 2};
                EpiResidNorm<true> E{xres, gx1, P.pool_scale, P.norm_ffn + layer * 1024, ada + (size_t)(layer * 2) * 6144 + 3 * 1024, (bf16_t*)(ws + O_HBUF), (float*)(ws + O_PART),
                                     (unsigned*)(ws + O_ZERO + 4096) + 2048, 0};
                gemm_phase(lds, 256, 256, 256, S, E); } break;
        }
      }
      }
        if (ph + 1 < P.ph_hi) { if (P.ph_hi > 4096) cg::this_grid().sync();
            xcd_barrier(xb); }
    }
}

extern "C" void kernel_launch(void* const* d_in, const int* in_sizes, int n_in, void* d_out, int out_size, void* d_ws, size_t ws_size, hipStream_t stream) {
    static int grid = 0;
    if (grid == 0) {
        if (n_in != 21 || ws_size < WS_END) { fprintf(stderr, "kernel_launch: need 21 inputs and %zu bytes of workspace, got %d / %zu\n", (size_t)WS_END, n_in, ws_size); grid = -1; return; }
        int dev = 0, cus = 0, per_cu = 0;
        (void)hipGetDevice(&dev); (void)hipDeviceGetAttribute(&cus, hipDeviceAttributeMultiprocessorCount, dev);
        if (hipFuncSetAttribute((const void*)mega_fwd, hipFuncAttributeMaxDynamicSharedMemorySize, LDS_ALLOC) != hipSuccess) { fprintf(stderr, "kernel_launch: hipFuncSetAttribute failed\n"); grid = -1; return; }
        if (hipOccupancyMaxActiveBlocksPerMultiprocessor(&per_cu, (const void*)mega_fwd, NTHR, LDS_ALLOC) != hipSuccess || per_cu < 1) { fprintf(stderr, "kernel_launch: occupancy query gives %d\n", per_cu); per_cu = 1; }
        (void)hipGetLastError();
        grid = cus;
        if (grid != 256) { fprintf(stderr, "kernel_launch: built for 256 CUs (fused residual+norm epilogues need one unit per workgroup), got %d\n", grid); grid = -1; return; }
    }
    if (grid < 0) return;
    if (hipMemsetAsync((char*)d_ws + O_BAR, 0, 32768, stream) != hipSuccess) { fprintf(stderr, "kernel_launch: memset failed\n"); return; }
    Params p{};
    const float** pp = (const float**)&p;
    for (int i = 0; i < 21; ++i) pp[i] = (const float*)d_in[i];
    p.out = (float*)d_out; p.ws = (unsigned char*)d_ws;
#if N_LAUNCH_MODE == 1
    p.ph_lo = 0; p.ph_hi = NPHASE;
    void* args[] = {&p};
    hipError_t e = hipLaunchCooperativeKernel((const void*)mega_fwd, dim3(grid), dim3(NTHR), args, LDS_ALLOC, stream);
    if (e != hipSuccess) fprintf(stderr, "cooperative launch failed: %s (grid %d)\n", hipGetErrorString(e), grid);
#else
    for (int ph = 0; ph < NPHASE; ++ph) { p.ph_lo = ph; p.ph_hi = ph + 1; hipLaunchKernelGGL(mega_fwd, dim3(grid), dim3(NTHR), LDS_ALLOC, stream, p); }
#endif
}
```

```cpp
#include <hip/hip_runtime.h>
#include <hip/hip_cooperative_groups.h>
#include <cstdio>
namespace cg = cooperative_groups;

#ifndef DEFER
#define DEFER 1
#endif
#ifndef DEFER_HOOKS
#define DEFER_HOOKS 1
#endif
#ifndef MOE_SPLIT
#define MOE_SPLIT 1
#endif
#ifndef N_LAUNCH_MODE
#define N_LAUNCH_MODE 1
#endif

#define LAS __attribute__((address_space(3)))
typedef unsigned short bf16_t;
typedef short bf16x8 __attribute__((ext_vector_type(8)));
typedef float f32x4 __attribute__((ext_vector_type(4)));
typedef float f32x16 __attribute__((ext_vector_type(16)));
typedef unsigned u32x4 __attribute__((ext_vector_type(4)));
typedef unsigned u32x2 __attribute__((ext_vector_type(2)));
typedef float f32x2 __attribute__((ext_vector_type(2)));

constexpr int D = 1024, SEQ = 16384, CTXL = 256, MTOT = SEQ + CTXL, DFF = 3584, NEXP = 8;
constexpr int NTHR = 512, NWAVE = 8;
constexpr int KSPL = 7, KCH = DFF / KSPL;
constexpr int LDS_BYTES = 131072, LDS_ALLOC = LDS_BYTES + 16;
constexpr int MOE_ROWS = 2 * SEQ + NEXP * 256;

constexpr size_t O_CTL   = 0;
constexpr int CSTR = 64;
constexpr size_t O_ADA   = 4096;
constexpr size_t O_TW    = O_ADA + 4 * 2 * 6 * 1024 * 4;
constexpr size_t O_ROPE  = O_TW + 16384 * 8;
constexpr size_t O_FM1   = O_ROPE + 256 * 16 * 8;
constexpr size_t O_FM2   = O_FM1 + 131072;
constexpr size_t O_FC    = O_FM2 + 131072;
constexpr size_t O_ROUTE = O_FC + 262144;
constexpr size_t O_RW    = O_ROUTE + 262144;
constexpr size_t O_WFT   = O_RW + 131072;
constexpr size_t O_WQKV  = O_WFT + (size_t)2 * 2048 * 1024 * 2;
constexpr size_t O_WO    = O_WQKV + (size_t)1536 * 1024 * 2;
constexpr size_t O_POOLW = O_WO + (size_t)1024 * 1024 * 2;
constexpr size_t O_FWI   = O_POOLW + (size_t)1024 * 256 * 2;
constexpr size_t O_FWO   = O_FWI + (size_t)2 * 7168 * 1024 * 2;
constexpr size_t O_MWI   = O_FWO + (size_t)2 * 1024 * 3584 * 2;
constexpr size_t O_MWO   = O_MWI + (size_t)16 * 7168 * 1024 * 2;
constexpr size_t O_XRES  = O_MWO + (size_t)16 * 1024 * 3584 * 2;
constexpr size_t O_HBUF  = O_XRES + (size_t)MTOT * 1024 * 4;
constexpr size_t O_ZT    = O_HBUF + (size_t)MTOT * 1024 * 2;
constexpr size_t O_ZCT   = O_ZT + (size_t)131072 * 256 * 2;
constexpr size_t O_YP    = O_ZCT + (size_t)1024 * 512 * 2;
constexpr size_t O_HID   = O_YP + (size_t)131072 * 256 * 2;
constexpr size_t O_QK    = O_HID + (size_t)MTOT * 3584 * 2;
constexpr size_t O_VT    = O_QK + (size_t)MTOT * 1280 * 2;
constexpr size_t O_AO    = O_VT + (size_t)256 * MTOT * 2;
constexpr size_t O_HS    = O_AO + (size_t)SEQ * 1024 * 2;
constexpr size_t O_HIDS  = O_HS + (size_t)MOE_ROWS * 1024 * 2;
constexpr size_t O_YS    = O_HIDS + (size_t)MOE_ROWS * 3584 * 2;
constexpr size_t O_POOL  = O_YS + (size_t)MOE_ROWS * 1024 * 4;
constexpr size_t O_BAR   = O_POOL + (size_t)65536 * 256 * 2;
constexpr size_t O_FWT   = O_BAR + 32768;
constexpr size_t O_TMAT  = O_FWT + (size_t)2 * 1024 * 1024 * 2;
constexpr size_t O_ZERO  = O_BAR + 16384;
constexpr size_t O_YSP   = O_TMAT + 512 * 256 * 2;
constexpr size_t O_BLK   = O_YSP + (size_t)KSPL * 2048 * 1024 * 4;
constexpr size_t O_SROW  = O_BLK + 1024 * 8 * 4;
constexpr size_t O_INV   = O_SROW + 16384 * 8;
constexpr size_t O_PART  = O_INV + (size_t)MOE_ROWS * 4;
constexpr size_t WS_END  = O_PART + 64 * 4 * 256 * 4;

struct Params {
    const float *x, *c, *ctx, *c_ctx, *ada_w, *ada_b, *norm_mix, *norm_ffn, *fnet_w, *wqkv, *q_gain, *k_gain, *sink, *attn_wo,
        *pool_w, *pool_scale, *ffn_wi, *ffn_wo, *router, *moe_wi, *moe_wo;
    float* out; unsigned char* ws; int ph_lo, ph_hi;
};

__device__ __forceinline__ unsigned pk2(float lo, float hi) { unsigned r; asm("v_cvt_pk_bf16_f32 %0, %1, %2" : "=v"(r) : "v"(lo), "v"(hi)); return r; }
__device__ __forceinline__ int get_tid() { int t = threadIdx.x; asm volatile("" : "+v"(t)); return t; }
__device__ __forceinline__ int get_bid() { int b = blockIdx.x; asm volatile("" : "+s"(b)); return b; }
__device__ __forceinline__ float bf2f(bf16_t b) { return __uint_as_float(((unsigned)b) << 16); }
__device__ __forceinline__ float bflo(unsigned u) { return __uint_as_float(u << 16); }
__device__ __forceinline__ float bfhi(unsigned u) { return __uint_as_float(u & 0xFFFF0000u); }
__device__ __forceinline__ float wave_sum(float v) {
#pragma unroll
    for (int o = 1; o < 64; o <<= 1) v += __shfl_xor(v, o);
    return v;
}
__device__ __forceinline__ int xcd_remap(int L, int nwg) { const int q = nwg >> 3, r = nwg & 7, xcd = L & 7, off = L >> 3; return (xcd < r ? xcd * (q + 1) : r * (q + 1) + (xcd - r) * q) + off; }
__device__ __forceinline__ float silu_f(float v) { return v * __builtin_amdgcn_rcpf(1.f + __expf(-v)); }


#define XB_TMO      128
#define XB_XCNT(j)  (256  + 64 * (j))
#define XB_XSUB(j)  (1280 + 64 * (j))
#define XB_XGEN(j)  (2304 + 64 * (j))
#define XB_TOP      3328
#define XB_TOPGEN   3392
#define XCD_BAR_WORDS 3456
#define XB_SPIN_CAP (1u << 18)
__device__ __forceinline__ unsigned xb_ld(unsigned* p)              { return __hip_atomic_load(p, __ATOMIC_RELAXED, __HIP_MEMORY_SCOPE_AGENT); }
__device__ __forceinline__ unsigned xb_add(unsigned* p, unsigned v) { return __hip_atomic_fetch_add(p, v, __ATOMIC_RELAXED, __HIP_MEMORY_SCOPE_AGENT); }
__device__ __forceinline__ unsigned xb_xcc_id() { return (unsigned)__builtin_amdgcn_s_getreg((3 << 11) | 20) & 0xFu; }
#define XB_SPIN(cond, bar) do { unsigned _sp = 0; while (cond) { __builtin_amdgcn_s_sleep(1); \
    if ((++_sp & 255u) == 0u) { if (xb_ld(&(bar)[XB_TMO])) break; if (_sp > XB_SPIN_CAP) { atomicAdd(&(bar)[XB_TMO], 1u); break; } } } } while (0)
struct XcdBarrier { unsigned* bar; unsigned x; volatile LAS unsigned* st; };
__device__ __forceinline__ XcdBarrier xcd_barrier_post(unsigned* bar, volatile LAS unsigned* st) {
    XcdBarrier b; b.bar = bar; b.x = xb_xcc_id(); b.st = st;
    if (threadIdx.x == 0) (void)xb_add(&bar[XB_XCNT(b.x)], 1u);
    return b;
}
__device__ __forceinline__ void xcd_barrier_complete(unsigned* bar, unsigned x, unsigned& nloc, unsigned& nx) {
    const unsigned G = gridDim.x * gridDim.y * gridDim.z;
    unsigned sum, cnt, mine, sp = 0u;
    for (;;) {
        sum = 0u; cnt = 0u; mine = 0u;
#pragma unroll
        for (unsigned j = 0; j < 16; ++j) { const unsigned c = xb_ld(&bar[XB_XCNT(j)]); sum += c; cnt += (c > 0u) ? 1u : 0u; mine = (j == x) ? c : mine; }
        if (sum == G) break;
        __builtin_amdgcn_s_sleep(1);
        if ((++sp & 255u) == 0u) { if (xb_ld(&bar[XB_TMO])) break; if (sp > XB_SPIN_CAP) { atomicAdd(&bar[XB_TMO], 1u); break; } }
    }
    nloc = mine > 0u ? mine : 1u; nx = cnt > 0u ? cnt : 1u;
}
__device__ __forceinline__ void xcd_barrier(const XcdBarrier& b) {
    asm volatile("s_waitcnt vmcnt(0)" ::: "memory");
    __syncthreads();
    if (threadIdx.x == 0) {
        unsigned* bar = b.bar;
        __builtin_amdgcn_s_waitcnt(0);
        unsigned nloc = b.st[0], nx = b.st[1];
        if (nloc == 0u) { xcd_barrier_complete(bar, b.x, nloc, nx); b.st[0] = nloc; b.st[1] = nx; }
        const unsigned old = xb_add(&bar[XB_XSUB(b.x)], 1u);
        const unsigned gen = old / nloc;
        if (old + 1u == (gen + 1u) * nloc) {
            __builtin_amdgcn_fence(__ATOMIC_RELEASE, "agent");
            asm volatile("s_waitcnt vmcnt(0)" ::: "memory");
            const unsigned og = xb_add(&bar[XB_TOP], 1u);
            const unsigned tg = og / nx;
            if (og + 1u == (tg + 1u) * nx) xb_add(&bar[XB_TOPGEN], 1u);
            else XB_SPIN(xb_ld(&bar[XB_TOPGEN]) == tg, bar);
            __builtin_amdgcn_fence(__ATOMIC_ACQUIRE, "agent");
            xb_add(&bar[XB_XGEN(b.x)], 1u);
            asm volatile("s_waitcnt vmcnt(0)" ::: "memory");
        } else {
            XB_SPIN(xb_ld(&bar[XB_XGEN(b.x)]) == gen, bar);
            __builtin_amdgcn_fence(__ATOMIC_ACQUIRE, "agent");
            asm volatile("s_waitcnt vmcnt(0)" ::: "memory");
        }
    }
    __syncthreads();
}

constexpr int BM = 256, BK = 64, HALF = 128, HTB = HALF * BK * 2, WGM = 8;
__device__ __forceinline__ int lds_byte(int r, int c) { const int st = (r >> 4) * 2 + (c >> 5), rr = r & 15, cc = c & 31, ob = rr * 64 + cc * 2; return st * 1024 + (ob ^ (((ob >> 9) & 1) << 5)); }
__device__ __forceinline__ void stage_rc(int b, int& R, int& C) { const int st = b / 1024, sb = b % 1024, swz = sb ^ (((sb >> 9) & 1) << 5); R = (st >> 1) * 16 + swz / 64; C = (st & 1) * 32 + (swz % 64) / 2; }
__device__ __forceinline__ int perm32(int rho) { const int n = rho >> 4, i = rho & 15; return 8 * (i >> 2) + 4 * n + (i & 3); }

struct Unit { int pm, pn; const char* a; const char* b; };

struct SchedGrid {   static constexpr bool GATHER = false;
    int nM, nN, nwg, boff = 0; const char* A; const char* B; size_t tstep;
    __device__ __forceinline__ void init(const void* A_, const void* B_, int M, int N, int K) { nM = M / BM; nN = N / BM; nwg = nM * nN; A = (const char*)A_; B = (const char*)B_; tstep = (size_t)BM * K * 2; }
    __device__ __forceinline__ bool next(int i, Unit& u) const {
        const int G = (int)gridDim.x; int vb = get_bid() + boff; vb = vb >= G ? vb - G : vb;
        const int L = i * G + vb; if (L >= nwg) return false;
        const int wgid = xcd_remap(L, nwg);
        const int nig = WGM * nN, gid = wgid / nig, fm = gid * WGM, gsz = (nM - fm) < WGM ? (nM - fm) : WGM;
        u.pm = fm + ((wgid % nig) % gsz); u.pn = (wgid % nig) / gsz;
        u.a = A + (size_t)u.pm * tstep; u.b = B + (size_t)u.pn * tstep; return true;
    }
};
struct SchedPool {   static constexpr bool GATHER = false;
    const char* A; const char* B; size_t tstep;
    __device__ __forceinline__ bool next(int i, Unit& u) const {
        const int L = i * (int)gridDim.x + get_bid(); if (L >= 256) return false;
        const int wgid = xcd_remap(L, 256);
        u.pm = wgid; u.pn = wgid >> 6; u.a = A + (size_t)u.pm * tstep; u.b = B + (size_t)u.pn * tstep; return true;
    }
};
struct SchedFold {   static constexpr bool GATHER = false;
    const char* A; const char* B;
    __device__ __forceinline__ bool next(int i, Unit& u) const {
        const int L = i * (int)gridDim.x + get_bid(); if (L >= 64) return false;
        const int c = L & 1, pm = (L >> 1) & 3, g = (L >> 3) & 3, j = L >> 5;
        u.pm = ((j * 4 + g) << 2) + pm; u.pn = c;
        u.a = A + ((size_t)j * 1024 * 1024 + (size_t)pm * 256 * 1024 + g * 256) * 2; u.b = B + (size_t)c * 256 * 256 * 2; return true;
    }
};
struct SchedSplit {   static constexpr bool GATHER = false;
    const int* cnt; int tile0, ntile, moe; const char* A; const char* B; size_t estride;
    __device__ __forceinline__ bool next(int i, Unit& u) const {
        const int L = i * (int)gridDim.x + get_bid(); if (L >= ntile * 4 * KSPL) return false;
        const int t = L / (4 * KSPL), rem = L % (4 * KSPL), ks = rem >> 2, pn = rem & 3, pm = tile0 + t;
        int es = 0;
        if (moe) { int a2 = 0;
#pragma unroll
            for (int e = 0; e < NEXP; ++e) { const int tt = (cnt[e * CSTR] + 255) >> 8; if (pm >= a2 && pm < a2 + tt) es = e; a2 += tt; } }
        u.pm = t; u.pn = pn * KSPL + ks;
        u.a = A + ((size_t)pm * 256 * DFF + ks * KCH) * 2; u.b = B + (size_t)es * estride + ((size_t)pn * 256 * DFF + ks * KCH) * 2; return true;
    }
};
template <bool GATHER_> struct SchedMoeT {    static constexpr bool GATHER = GATHER_; const int* inv = nullptr; const char* abase = nullptr;
    const int* cnt; int nN, T, rowmajor; const char* A; const char* B; size_t tstep, estride; int tl[NEXP];
    __device__ __forceinline__ void init(const int* cnt_, const void* A_, const void* B_, int N, int K, int rowmajor_, int maxT) {
        rowmajor = rowmajor_;
        cnt = cnt_; nN = N / BM; A = (const char*)A_; B = (const char*)B_; tstep = (size_t)BM * K * 2; estride = (size_t)N * K * 2;
        int t = 0;
#pragma unroll
        for (int e = 0; e < NEXP; ++e) { tl[e] = __builtin_amdgcn_readfirstlane((cnt[e * CSTR] + 255) >> 8); t += tl[e]; }
        T = t < maxT ? t : maxT;
    }
    __device__ __forceinline__ bool next(int i, Unit& u) const {
        const int nwg = T * nN; const int L = i * (int)gridDim.x + get_bid(); if (L >= nwg) return false;
        const int wgid = xcd_remap(L, nwg);
        int acc = 0, es = 0, ts = 0, te = 1;
#pragma unroll
        for (int e = 0; e < NEXP; ++e) { const int t = tl[e]; if (wgid >= acc * nN && wgid < (acc + t) * nN) { es = e; ts = acc; te = t; } acc += t; }
        const int r = wgid - ts * nN; u.pm = ts + r % te; u.pn = r / te;
        if (rowmajor) { u.pm = wgid / nN; u.pn = wgid % nN; int a2 = 0;
#pragma unroll
            for (int e = 0; e < NEXP; ++e) { const int t = tl[e]; if (u.pm >= a2 && u.pm < a2 + t) es = e; a2 += t; } }
        u.a = A + (size_t)u.pm * tstep; u.b = B + (size_t)es * estride + (size_t)u.pn * tstep; return true;
    }
};

template <class Epi, class Sched>
__device__ __forceinline__ void gemm_phase(LAS unsigned char* lds, const int K, const int lda, const int ldb, const Sched& S, const Epi& E) {
    const int tid = get_tid(), wid = __builtin_amdgcn_readfirstlane(tid >> 6), lane = tid & 63, wr = wid >> 2, wc = wid & 3, fr = lane & 15, fq = lane >> 4;
    const int nt = K / BK;
    constexpr bool GATHER = Sched::GATHER;
    unsigned voffA[2], voffB[2];
#pragma unroll
    for (int i = 0; i < 2; ++i) { int R, C; stage_rc(tid * 16 + i * 8192, R, C); const int Rb = Epi::PERM ? ((R & ~31) + perm32(R & 31)) : R;
        voffA[i] = (unsigned)(R * lda + C) * 2u; voffB[i] = (unsigned)(Rb * ldb + C) * 2u; }
    unsigned vcur[2][2] = {{0u, 0u}, {0u, 0u}}, vnxt[2][2] = {{0u, 0u}, {0u, 0u}}; int ix1[2][2] = {{0, 0}, {0, 0}};
    const int* invp = nullptr; if constexpr (GATHER) invp = S.inv;
    auto ld_ix = [&](int pm, int (&ix)[2][2]) {
#pragma unroll
        for (int i = 0; i < 2; ++i) { int R, C; stage_rc(get_tid() * 16 + i * 8192, R, C);
#pragma unroll
            for (int h = 0; h < 2; ++h) ix[h][i] = invp[pm * BM + h * HALF + R]; } };
    auto mk_off = [&](const int (&ix)[2][2], unsigned (&vo)[2][2]) {
#pragma unroll
        for (int i = 0; i < 2; ++i) { int R, C; stage_rc(get_tid() * 16 + i * 8192, R, C);
#pragma unroll
            for (int h = 0; h < 2; ++h) vo[h][i] = (unsigned)ix[h][i] * (unsigned)(lda * 2) + (unsigned)C * 2u; } };
    const size_t kstep = (size_t)(BK * 2);
    const size_t hstepA = (size_t)HALF * lda * 2, hstepB = (size_t)HALF * ldb * 2;
    const unsigned ldsw = (unsigned)wid * 1024u;
    const int aoff = lds_byte(wr * 64 + fr, fq * 8), boff = lds_byte(wc * 32 + fr, fq * 8);
#define PG8_SA(b, h) (((b) * 2 + (h)) * HTB)
#define PG8_SB(b, h) ((4 + (b) * 2 + (h)) * HTB)
#define PG8_STAGE(bufoff, gbase, voff) do { _Pragma("unroll") for (int _i = 0; _i < 2; ++_i) \
        __builtin_amdgcn_global_load_lds((const unsigned*)((const char*)(gbase) + (voff)[_i]), (LAS unsigned*)(lds + (bufoff) + ldsw + _i * 8192), 16, 0, 0); } while (0)
#define PG8_STAGE_A(bufoff, gbase, h, vv) do { if constexpr (GATHER) { _Pragma("unroll") for (int _i = 0; _i < 2; ++_i) \
        __builtin_amdgcn_global_load_lds((const unsigned*)((const char*)(gbase) + (vv)[h][_i]), (LAS unsigned*)(lds + (bufoff) + ldsw + _i * 8192), 16, 0, 0); } \
        else { PG8_STAGE(bufoff, (gbase) + (h) * hstepA, voffA); } } while (0)
#define PG8_LDA(dst, b, h) do { _Pragma("unroll") for (int m = 0; m < 4; ++m) _Pragma("unroll") for (int k = 0; k < 2; ++k) dst[m][k] = *(const LAS bf16x8*)(lds + PG8_SA(b, h) + aoff + m * 2048 + k * 1024); } while (0)
#define PG8_LDB(dst, b, h) do { _Pragma("unroll") for (int n = 0; n < 2; ++n) _Pragma("unroll") for (int k = 0; k < 2; ++k) dst[n][k] = *(const LAS bf16x8*)(lds + PG8_SB(b, h) + boff + n * 2048 + k * 1024); } while (0)
#define PG8_MMA(ai, bj, At, Bt) do { __builtin_amdgcn_s_setprio(1); _Pragma("unroll") for (int m = 0; m < 4; ++m) _Pragma("unroll") for (int n = 0; n < 2; ++n) _Pragma("unroll") for (int k = 0; k < 2; ++k) \
        acc[ai][bj][m][n] = __builtin_amdgcn_mfma_f32_16x16x32_bf16(Bt[n][k], At[m][k], acc[ai][bj][m][n], 0, 0, 0); __builtin_amdgcn_s_setprio(0); } while (0)
#define PG8_WAIT_V(n) asm volatile("s_waitcnt vmcnt(" #n ")" ::: "memory")
#define PG8_WAIT_L(n) asm volatile("s_waitcnt lgkmcnt(" #n ")" ::: "memory")
#define PG8_BAR __builtin_amdgcn_s_barrier()
#define PG8_SCHED __builtin_amdgcn_sched_barrier(0)
    Unit cur, nxt; int ui = 0;
    if (!S.next(0, cur)) return;
    f32x4 acc[2][2][4][2];
#pragma unroll
    for (int a = 0; a < 2; ++a)
#pragma unroll
        for (int b = 0; b < 2; ++b)
#pragma unroll
            for (int m = 0; m < 4; ++m)
#pragma unroll
                for (int n = 0; n < 2; ++n) acc[a][b][m][n] = (f32x4){0.f, 0.f, 0.f, 0.f};
    bf16x8 At[4][2], B0[2][2], B1[2][2];
    const char* cA = cur.a; const char* cB = cur.b;
    bool has_n1 = false;
    if constexpr (GATHER) {
        cA = S.abase;
        { int ix0[2][2]; ld_ix(cur.pm, ix0); mk_off(ix0, vcur); }
        has_n1 = S.next(1, nxt);
        if (has_n1) ld_ix(nxt.pm, ix1);
        asm volatile("s_waitcnt vmcnt(0)" ::: "memory");
    }
    PG8_STAGE(PG8_SB(0, 0), cB, voffB); PG8_STAGE_A(PG8_SA(0, 0), cA, 0, vcur); PG8_STAGE(PG8_SB(0, 1), cB + hstepB, voffB); PG8_STAGE_A(PG8_SA(0, 1), cA, 1, vcur);
    if (wr == 1) PG8_BAR;
    PG8_WAIT_V(4); PG8_BAR;
    PG8_STAGE(PG8_SB(1, 0), cB + kstep, voffB); PG8_STAGE_A(PG8_SA(1, 0), cA + kstep, 0, vcur); PG8_STAGE(PG8_SB(1, 1), cB + hstepB + kstep, voffB);
    PG8_WAIT_V(6); PG8_BAR;
    for (;;) {
        const bool has_next = S.next(ui + 1, nxt);
        const char* nA = has_next ? nxt.a : cA; const char* nB = has_next ? nxt.b : cB;
        if constexpr (GATHER) {
            nA = cA;
            if (has_next) mk_off(ix1, vnxt);
            else {
#pragma unroll
                for (int h = 0; h < 2; ++h)
#pragma unroll
                    for (int i = 0; i < 2; ++i) vnxt[h][i] = vcur[h][i];
            }
        }
#pragma unroll 1
        for (int t = 0; t < nt; t += 2) {
            const bool last = (t == nt - 2);
            const char* a1 = cA + (size_t)(t + 1) * kstep;
            const char* a2 = last ? nA : cA + (size_t)(t + 2) * kstep; const char* b2 = last ? nB : cB + (size_t)(t + 2) * kstep;
            const char* a3 = a2 + kstep; const char* b3 = b2 + kstep;
            PG8_LDB(B0, 0, 0); PG8_SCHED; PG8_LDA(At, 0, 0); PG8_STAGE_A(PG8_SA(1, 1), a1, 1, vcur);
            if constexpr (GATHER) { if (last) {
#pragma unroll
                for (int h = 0; h < 2; ++h)
#pragma unroll
                    for (int i = 0; i < 2; ++i) vcur[h][i] = vnxt[h][i]; } }
            PG8_WAIT_L(8); PG8_BAR; PG8_WAIT_L(0); PG8_MMA(0, 0, At, B0); PG8_BAR; PG8_SCHED;
            PG8_LDB(B1, 0, 1); PG8_STAGE(PG8_SB(0, 0), b2, voffB);
            PG8_BAR; PG8_WAIT_L(0); PG8_MMA(0, 1, At, B1); PG8_BAR;
            PG8_LDA(At, 0, 1); PG8_STAGE_A(PG8_SA(0, 0), a2, 0, vcur);
            PG8_BAR; PG8_WAIT_L(0); PG8_MMA(1, 0, At, B0); PG8_BAR; PG8_SCHED;
            PG8_STAGE(PG8_SB(0, 1), b2 + hstepB, voffB);
            PG8_WAIT_V(6); PG8_BAR; PG8_MMA(1, 1, At, B1); PG8_BAR;
            PG8_LDB(B0, 1, 0); PG8_SCHED; PG8_LDA(At, 1, 0); PG8_STAGE_A(PG8_SA(0, 1), a2, 1, vcur);
            PG8_WAIT_L(8); PG8_BAR; PG8_WAIT_L(0); PG8_MMA(0, 0, At, B0); PG8_BAR; PG8_SCHED;
            PG8_LDB(B1, 1, 1); PG8_STAGE(PG8_SB(1, 0), b3, voffB);
            PG8_BAR; PG8_WAIT_L(0); PG8_MMA(0, 1, At, B1); PG8_BAR;
            PG8_LDA(At, 1, 1); PG8_STAGE_A(PG8_SA(1, 0), a3, 0, vcur);
            PG8_BAR; PG8_WAIT_L(0); PG8_MMA(1, 0, At, B0); PG8_BAR; PG8_SCHED;
            PG8_STAGE(PG8_SB(1, 1), b3 + hstepB, voffB);
            PG8_WAIT_V(6); PG8_BAR; PG8_MMA(1, 1, At, B1); PG8_BAR;
        }
        if constexpr (GATHER) { Unit n2; if (has_next && S.next(ui + 2, n2)) ld_ix(n2.pm, ix1); }
        if constexpr (!Epi::AFTER_DRAIN) E(acc, cur, wr, wc, fr, fq);
        if (!has_next) break;
#pragma unroll
        for (int a = 0; a < 2; ++a)
#pragma unroll
            for (int b = 0; b < 2; ++b)
#pragma unroll
                for (int m = 0; m < 4; ++m)
#pragma unroll
                    for (int n = 0; n < 2; ++n) acc[a][b][m][n] = (f32x4){0.f, 0.f, 0.f, 0.f};
        cur = nxt; cA = nA; cB = nB; ++ui;

    }
    PG8_WAIT_V(0);
    if (wr == 0) PG8_BAR;
    PG8_BAR;
    if constexpr (Epi::AFTER_DRAIN) E.fused(acc, cur, wr, wc, fr, fq, lds);
#undef PG8_SA
#undef PG8_SB
#undef PG8_STAGE
#undef PG8_STAGE_A
#undef PG8_LDA
#undef PG8_LDB
#undef PG8_MMA
#undef PG8_WAIT_V
#undef PG8_WAIT_L
#undef PG8_BAR
#undef PG8_SCHED
}

typedef f32x4 Acc[2][2][4][2];

struct EpiStoreBf16 {
    static constexpr bool PERM = true, AFTER_DRAIN = false; bf16_t* O; size_t ld;
    __device__ __forceinline__ void operator()(const Acc& acc, const Unit& u, int wr, int wc, int fr, int fq) const {
        const int row0 = u.pm * BM + wr * 64 + fr, col0 = u.pn * BM + wc * 32 + 8 * fq;
#pragma unroll
        for (int ai = 0; ai < 2; ++ai)
#pragma unroll
            for (int m = 0; m < 4; ++m) { bf16_t* rp = O + (size_t)(row0 + ai * HALF + m * 16) * ld + col0;
#pragma unroll
                for (int bj = 0; bj < 2; ++bj) { const f32x4 v0 = acc[ai][bj][m][0], v1 = acc[ai][bj][m][1];
                    u32x4 o; o.x = pk2(v0[0], v0[1]); o.y = pk2(v0[2], v0[3]); o.z = pk2(v1[0], v1[1]); o.w = pk2(v1[2], v1[3]);
                    *(u32x4*)(rp + bj * HALF) = o; } }
    }
};
struct EpiFold {
    static constexpr bool PERM = true, AFTER_DRAIN = false; bf16_t* W;
    __device__ __forceinline__ void operator()(const Acc& acc, const Unit& u, int wr, int wc, int fr, int fq) const {
        const int pm = u.pm & 3, jg = u.pm >> 2, j = jg >> 2, g = jg & 3;
        const int row0 = pm * BM + wr * 64 + fr, col0 = wc * 32 + 8 * fq;
        bf16_t* base = W + ((size_t)j * 2048 + (size_t)u.pn * 1024) * 1024 + g * 256;
#pragma unroll
        for (int ai = 0; ai < 2; ++ai)
#pragma unroll
            for (int m = 0; m < 4; ++m) { bf16_t* rp = base + (size_t)(row0 + ai * HALF + m * 16) * 1024 + col0;
#pragma unroll
                for (int bj = 0; bj < 2; ++bj) { const f32x4 v0 = acc[ai][bj][m][0], v1 = acc[ai][bj][m][1];
                    u32x4 o; o.x = pk2(v0[0], v0[1]); o.y = pk2(v0[2], v0[3]); o.z = pk2(v1[0], v1[1]); o.w = pk2(v1[2], v1[3]);
                    *(u32x4*)(rp + bj * HALF) = o; } }
    }
};
struct EpiPartial {
    static constexpr bool PERM = false, AFTER_DRAIN = false; float* Yp;
    __device__ __forceinline__ void operator()(const Acc& acc, const Unit& u, int wr, int wc, int fr, int fq) const {
        const int ks = u.pn % KSPL, pn = u.pn / KSPL;
        const int row0 = u.pm * BM + wr * 64 + fr, col0 = pn * BM + wc * 32 + 4 * fq;
        float* base = Yp + (size_t)ks * 2048 * D;
#pragma unroll
        for (int ai = 0; ai < 2; ++ai)
#pragma unroll
            for (int m = 0; m < 4; ++m) { float* rp = base + (size_t)(row0 + ai * HALF + m * 16) * D + col0;
#pragma unroll
                for (int bj = 0; bj < 2; ++bj)
#pragma unroll
                    for (int n = 0; n < 2; ++n) *(f32x4*)(rp + bj * HALF + n * 16) = acc[ai][bj][m][n]; }
    }
};
struct EpiStoreF32 {
    static constexpr bool PERM = false, AFTER_DRAIN = false; float* C; size_t ld;
    __device__ __forceinline__ void operator()(const Acc& acc, const Unit& u, int wr, int wc, int fr, int fq) const {
        const int row0 = u.pm * BM + wr * 64 + fr, col0 = u.pn * BM + wc * 32 + 4 * fq;
#pragma unroll
        for (int ai = 0; ai < 2; ++ai)
#pragma unroll
            for (int m = 0; m < 4; ++m) { float* rp = C + (size_t)(row0 + ai * HALF + m * 16) * ld + col0;
#pragma unroll
                for (int bj = 0; bj < 2; ++bj)
#pragma unroll
                    for (int n = 0; n < 2; ++n) *(f32x4*)(rp + bj * HALF + n * 16) = acc[ai][bj][m][n]; }
    }
};
struct EpiResid {
    static constexpr bool PERM = false, AFTER_DRAIN = false; float* X; const float* gate_x; const float* gate_c;
    __device__ __forceinline__ void operator()(const Acc& acc, const Unit& u, int wr, int wc, int fr, int fq) const {
        const int row0 = u.pm * BM + wr * 64 + fr, col0 = u.pn * BM + wc * 32 + 4 * fq;
        const float* gp = (u.pm < SEQ / BM) ? gate_x : gate_c;
        f32x4 gv[2][2];
#pragma unroll
        for (int bj = 0; bj < 2; ++bj)
#pragma unroll
            for (int n = 0; n < 2; ++n) gv[bj][n] = *(const f32x4*)(gp + col0 + bj * HALF + n * 16);
#pragma unroll
        for (int ai = 0; ai < 2; ++ai)
#pragma unroll
            for (int m = 0; m < 4; ++m) { float* rp = X + (size_t)(row0 + ai * HALF + m * 16) * D + col0;
#pragma unroll
                for (int bj = 0; bj < 2; ++bj)
#pragma unroll
                    for (int n = 0; n < 2; ++n) { f32x4* p = (f32x4*)(rp + bj * HALF + n * 16); *p = *p + gv[bj][n] * acc[ai][bj][m][n]; } }
    }
};
template <bool POOL> struct EpiResidNorm {
    static constexpr bool PERM = false, AFTER_DRAIN = true;
    float* X; const float* gate; const float* scale; const float* gain; const float* adap  ; bf16_t* H; float* part; unsigned* cnt; int permute;
    __device__ __forceinline__ void operator()(const Acc&, const Unit&, int, int, int, int) const {}
    __device__ __forceinline__ void fused(Acc& acc, const Unit& u, int wr, int wc, int fr, int fq, LAS unsigned char* lds) const {
        const int tid = get_tid();
        const int owner = POOL ? u.pn : u.pn, panel = POOL ? (u.pm - 64 * u.pn) : u.pm;
        const int row0 = panel * BM + wr * 64 + fr, col0 = u.pn * BM + wc * 32 + 4 * fq;
        LAS float* psum = (LAS float*)lds; LAS float* rs = (LAS float*)(lds + 4096);
#pragma unroll
        for (int bj = 0; bj < 2; ++bj)
#pragma unroll
            for (int n = 0; n < 2; ++n) { const int col = col0 + bj * HALF + n * 16;
                f32x4 gv = *(const f32x4*)(gate + col); if (POOL) gv = gv * *(const f32x4*)(scale + col);
#pragma unroll
                for (int ai = 0; ai < 2; ++ai)
#pragma unroll
                    for (int m = 0; m < 4; ++m) { f32x4* p = (f32x4*)(X + (size_t)(row0 + ai * HALF + m * 16) * D + col); const f32x4 xv = *p + gv * acc[ai][bj][m][n]; *p = xv; acc[ai][bj][m][n] = xv; }
                __builtin_amdgcn_sched_barrier(0); }
#pragma unroll
        for (int ai = 0; ai < 2; ++ai)
#pragma unroll
            for (int m = 0; m < 4; ++m) { float sq = 0.f;
#pragma unroll
                for (int bj = 0; bj < 2; ++bj)
#pragma unroll
                    for (int n = 0; n < 2; ++n) { const f32x4 v = acc[ai][bj][m][n]; sq += (v[0] * v[0] + v[1] * v[1]) + (v[2] * v[2] + v[3] * v[3]); }
                sq += __shfl_xor(sq, 16); sq += __shfl_xor(sq, 32);
                if (fq == 0) psum[wc * 256 + ai * HALF + wr * 64 + m * 16 + fr] = sq; }
        __syncthreads();
        if (tid < 256) __hip_atomic_store(part + (size_t)(panel * 4 + owner) * 256 + tid, (psum[tid] + psum[256 + tid]) + (psum[512 + tid] + psum[768 + tid]), __ATOMIC_RELAXED, __HIP_MEMORY_SCOPE_AGENT);
        asm volatile("s_waitcnt vmcnt(0)" ::: "memory");
        __syncthreads();
        if (tid == 0) { unsigned* c = cnt + panel * 16; __hip_atomic_fetch_add(c, 1u, __ATOMIC_RELAXED, __HIP_MEMORY_SCOPE_AGENT);
            unsigned sp = 0; while (__hip_atomic_load(c, __ATOMIC_RELAXED, __HIP_MEMORY_SCOPE_AGENT) < 4u) { __builtin_amdgcn_s_sleep(1); if (++sp > (1u << 22)) break; } }
        __syncthreads();
        if (tid < 256) { float* pp = part + (size_t)panel * 4 * 256 + tid;
            const float p0 = __hip_atomic_load(pp, __ATOMIC_RELAXED, __HIP_MEMORY_SCOPE_AGENT), p1 = __hip_atomic_load(pp + 256, __ATOMIC_RELAXED, __HIP_MEMORY_SCOPE_AGENT),
                        p2 = __hip_atomic_load(pp + 512, __ATOMIC_RELAXED, __HIP_MEMORY_SCOPE_AGENT), p3 = __hip_atomic_load(pp + 768, __ATOMIC_RELAXED, __HIP_MEMORY_SCOPE_AGENT);
            rs[tid] = rsqrtf(((p0 + p1) + (p2 + p3)) * (1.f / D) + 1e-6f); }
        __syncthreads();
#pragma unroll
        for (int bj = 0; bj < 2; ++bj)
#pragma unroll
            for (int n = 0; n < 2; ++n) { const int col = col0 + bj * HALF + n * 16;
                const f32x4 ga = *(const f32x4*)(gain + col) * (1.f + *(const f32x4*)(adap + 1024 + col)), sh = *(const f32x4*)(adap + col);
#pragma unroll
                for (int ai = 0; ai < 2; ++ai)
#pragma unroll
                    for (int m = 0; m < 4; ++m) { const int rt = ai * HALF + wr * 64 + m * 16 + fr, row = panel * BM + rt; const float r = rs[rt];
                        const f32x4 hv = acc[ai][bj][m][n] * r * ga + sh;
                        const int orow = permute ? (128 * (row & 127) + (row >> 7)) : row;
                        u32x2 o; o.x = pk2(hv[0], hv[1]); o.y = pk2(hv[2], hv[3]); *(u32x2*)(H + (size_t)orow * D + col) = o; }
                __builtin_amdgcn_sched_barrier(0); }
        __syncthreads();
    }
};
struct EpiSwiglu {
    static constexpr bool PERM = true, AFTER_DRAIN = false; bf16_t* Hd;
    __device__ __forceinline__ void operator()(const Acc& acc, const Unit& u, int wr, int wc, int fr, int fq) const {
        const int row0 = u.pm * BM + wr * 64 + fr, col0 = u.pn * HALF + wc * 32 + 8 * fq;
#pragma unroll
        for (int ai = 0; ai < 2; ++ai)
#pragma unroll
            for (int m = 0; m < 4; ++m) { bf16_t* rp = Hd + (size_t)(row0 + ai * HALF + m * 16) * DFF + col0;
                float h[8];
#pragma unroll
                for (int n = 0; n < 2; ++n)
#pragma unroll
                    for (int e = 0; e < 4; ++e) { const float g = acc[ai][0][m][n][e], up = acc[ai][1][m][n][e]; h[4 * n + e] = silu_f(g) * up; }
                u32x4 o; o.x = pk2(h[0], h[1]); o.y = pk2(h[2], h[3]); o.z = pk2(h[4], h[5]); o.w = pk2(h[6], h[7]);
                *(u32x4*)rp = o; }
    }
};
struct EpiFZ {
    static constexpr bool PERM = true, AFTER_DRAIN = false; bf16_t* Zt; bf16_t* ZcT;
    __device__ __forceinline__ void operator()(const Acc& acc, const Unit& u, int wr, int wc, int fr, int fq) const {
        const int row0 = u.pm * BM + wr * 64 + fr, col0 = u.pn * BM + wc * 32 + 8 * fq;
#pragma unroll
        for (int ai = 0; ai < 2; ++ai)
#pragma unroll
            for (int m = 0; m < 4; ++m) { const int np = row0 + ai * HALF + m * 16, c = np >> 10, n = np & 1023;
#pragma unroll
                for (int bj = 0; bj < 2; ++bj) { const int j = col0 + bj * HALF; const f32x4 v0 = acc[ai][bj][m][0], v1 = acc[ai][bj][m][1];
                    u32x4 o; o.x = pk2(v0[0], v0[1]); o.y = pk2(v0[2], v0[3]); o.z = pk2(v1[0], v1[1]); o.w = pk2(v1[2], v1[3]);
                    bf16_t* dst;
                    if (u.pn < SEQ / BM) { const int l1 = j >> 7, l2 = j & 127; dst = Zt + ((size_t)(n * 128 + l1) * 2 + c) * 128 + l2; }
                    else { const int l = j - SEQ; dst = ZcT + (size_t)(n * 2 + c) * 256 + l; }
                    *(u32x4*)dst = o; } }
    }
};
struct EpiStep1 {
    static constexpr bool PERM = true, AFTER_DRAIN = false; bf16_t* Yp; const float2* tw;
    __device__ __forceinline__ void operator()(const Acc& acc, const Unit& u, int wr, int wc, int fr, int fq) const {
        const int col0 = u.pn * BM + wc * 32 + 8 * fq;
#pragma unroll
        for (int m = 0; m < 4; ++m) { const int ka = wr * 64 + m * 16 + fr; const float2 st = tw[ka]; const float2 t0 = tw[ka * (col0 & 127)];
#pragma unroll
            for (int bj = 0; bj < 2; ++bj) { const int q = col0 + bj * HALF, n = q >> 7, l1 = q & 127;
                bf16_t* dst = Yp + ((size_t)(ka * 1024 + n) * 2) * 128 + l1;
                float2 t = t0;
#pragma unroll
                for (int nn = 0; nn < 2; ++nn) {
                    float yr[4], yi[4];
#pragma unroll
                    for (int e = 0; e < 4; ++e) { const float a = acc[0][bj][m][nn][e], b = acc[1][bj][m][nn][e];
                        yr[e] = a * t.x + b * t.y; yi[e] = b * t.x - a * t.y;
                        const float tx = t.x * st.x - t.y * st.y, ty = t.x * st.y + t.y * st.x; t.x = tx; t.y = ty; }
                    u32x2 o; o.x = pk2(yr[0], yr[1]); o.y = pk2(yr[2], yr[3]);
                    u32x2 p; p.x = pk2(yi[0], yi[1]); p.y = pk2(yi[2], yi[3]);
                    *(u32x2*)(dst + 4 * nn) = o; *(u32x2*)(dst + 128 + 4 * nn) = p; }
                __builtin_amdgcn_sched_barrier(0); } }
    }
};
struct EpiStep2 {
    static constexpr bool PERM = false, AFTER_DRAIN = false; float* X; const float* gate; const float* Xin;
    __device__ __forceinline__ void operator()(const Acc& acc, const Unit& u, int wr, int wc, int fr, int fq) const {
        const int col0 = u.pn * BM + wc * 32 + 4 * fq;
#pragma unroll
        for (int m = 0; m < 4; ++m) { const int kb = wr * 64 + m * 16 + fr;
#pragma unroll
            for (int bj = 0; bj < 2; ++bj)
#pragma unroll
                for (int n = 0; n < 2; ++n) { const int q = col0 + bj * HALF + n * 16, ka = q >> 10, nn = q & 1023;
                    const f32x4 g = *(const f32x4*)(gate + nn) * (1.f / 2048.f);
                    const size_t o = (size_t)(ka + 128 * kb) * D + nn; *(f32x4*)(X + o) = *(const f32x4*)(Xin + o) + g * acc[0][bj][m][n]; }
            if (m & 1) __builtin_amdgcn_sched_barrier(0); }
    }
};
struct EpiCtxDft {
    static constexpr bool PERM = false, AFTER_DRAIN = false; float* X; const float* gate;
    __device__ __forceinline__ void operator()(const Acc& acc, const Unit& u, int wr, int wc, int fr, int fq) const {
        const int row0 = wr * 64 + fr, col0 = u.pn * BM + wc * 32 + 4 * fq;
#pragma unroll
        for (int bj = 0; bj < 2; ++bj)
#pragma unroll
            for (int n = 0; n < 2; ++n) { const int col = col0 + bj * HALF + n * 16;
                const f32x4 g = *(const f32x4*)(gate + col) * (1.f / 256.f);
#pragma unroll
                for (int ai = 0; ai < 2; ++ai)
#pragma unroll
                    for (int m = 0; m < 4; ++m) { f32x4* p = (f32x4*)(X + (size_t)(SEQ + row0 + ai * HALF + m * 16) * D + col); *p = *p + g * acc[ai][bj][m][n]; }
                __builtin_amdgcn_sched_barrier(0); }
    }
};
struct EpiPool {
    static constexpr bool PERM = false, AFTER_DRAIN = false; float* X; const float* gate; const float* scale;
    __device__ __forceinline__ void operator()(const Acc& acc, const Unit& u, int wr, int wc, int fr, int fq) const {
        const int g = u.pn, row0 = (u.pm - 64 * g) * BM + wr * 64 + fr, col0 = g * BM + wc * 32 + 4 * fq;
#pragma unroll
        for (int bj = 0; bj < 2; ++bj)
#pragma unroll
            for (int n = 0; n < 2; ++n) { const int col = col0 + bj * HALF + n * 16;
                const f32x4 gv = *(const f32x4*)(gate + col) * *(const f32x4*)(scale + col);
#pragma unroll
                for (int ai = 0; ai < 2; ++ai)
#pragma unroll
                    for (int m = 0; m < 4; ++m) { f32x4* p = (f32x4*)(X + (size_t)(row0 + ai * HALF + m * 16) * D + col); *p = *p + gv * acc[ai][bj][m][n]; }
                __builtin_amdgcn_sched_barrier(0); }
    }
};

__device__ __forceinline__ void transpose_item(const float* W, int K, int N, bf16_t* WT, int mode, LAS float* scr, int item, int lane) {
    const int nblk = N / 32, kb = item / nblk, nb = item % nblk, k0 = 64 * kb, n0 = 32 * nb;
#pragma unroll 8
    for (int i = 0; i < 32; ++i) { const int kk = 2 * i + (lane >> 5); scr[kk * 33 + (lane & 31)] = W[(size_t)(k0 + kk) * N + n0 + (lane & 31)]; }
    asm volatile("s_waitcnt lgkmcnt(0)" ::: "memory");
    int r0 = n0;
    if (mode == 1) { const int half = n0 / DFF, t = n0 % DFF; r0 = (t / 128) * 256 + half * 128 + (t % 128); }
    const int c = lane & 7;
#pragma unroll
    for (int j = 0; j < 4; ++j) { const int n = (lane >> 3) + 8 * j; const LAS float* s = scr + (8 * c) * 33 + n;
        u32x4 o; o.x = pk2(s[0 * 33], s[1 * 33]); o.y = pk2(s[2 * 33], s[3 * 33]); o.z = pk2(s[4 * 33], s[5 * 33]); o.w = pk2(s[6 * 33], s[7 * 33]);
        *(u32x4*)(WT + (size_t)(r0 + n) * K + k0 + 8 * c) = o; }
    asm volatile("s_waitcnt lgkmcnt(0)" ::: "memory");
}

struct TDesc { const float* src; bf16_t* dst; int K, N; };
constexpr int TR_WI = 16 * 224, TR_WO = 56 * 32, TR_QKV = 16 * 48, TR_AO = 16 * 32, TR_PW = 4 * 8, TR_FW = 16 * 32;
constexpr int TR_NIT = 8 * TR_WI + 8 * TR_WO + TR_WI + TR_WO + TR_QKV + TR_AO + 2 * TR_FW + 4 * TR_PW;
constexpr int TR_DEF_DENSE = TR_WI + TR_WO, TR_DEF = TR_DEF_DENSE + 8 * TR_WI + 8 * TR_WO, DCH = 8;
__device__ __forceinline__ TDesc tr_mk(const float* W, int K, int N, bf16_t* WT, int mode, int item) {
    const int nblk = N / 32, kb = item / nblk, nb = item % nblk, k0 = 64 * kb, n0 = 32 * nb;
    int r0 = n0;
    if (mode == 1) { const int half = n0 / DFF, t = n0 % DFF; r0 = (t / 128) * 256 + half * 128 + (t % 128); }
    TDesc d; d.src = W + (size_t)k0 * N + n0; d.dst = WT + (size_t)r0 * K + k0; d.K = K; d.N = N; return d;
}
__device__ __forceinline__ TDesc tr_decode(const Params& P, unsigned char* ws, int it, int deferred) {
    int r = it;
    if (deferred) {
        if (r < TR_WI) return tr_mk(P.ffn_wi + (size_t)1024 * 7168, 1024, 7168, (bf16_t*)(ws + O_FWI) + (size_t)7168 * 1024, 1, r); r -= TR_WI;
        if (r < TR_WO) return tr_mk(P.ffn_wo + (size_t)3584 * 1024, 3584, 1024, (bf16_t*)(ws + O_FWO) + (size_t)1024 * 3584, 0, r); r -= TR_WO;
        if (r < 8 * TR_WI) { const int e = 8 + r / TR_WI; return tr_mk(P.moe_wi + (size_t)e * 1024 * 7168, 1024, 7168, (bf16_t*)(ws + O_MWI) + (size_t)e * 7168 * 1024, 1, r % TR_WI); } r -= 8 * TR_WI;
        { const int e = 8 + r / TR_WO; return tr_mk(P.moe_wo + (size_t)e * 3584 * 1024, 3584, 1024, (bf16_t*)(ws + O_MWO) + (size_t)e * 1024 * 3584, 0, r % TR_WO); }
    }
    if (r < 8 * TR_WI) { const int e = r / TR_WI; return tr_mk(P.moe_wi + (size_t)e * 1024 * 7168, 1024, 7168, (bf16_t*)(ws + O_MWI) + (size_t)e * 7168 * 1024, 1, r % TR_WI); } r -= 8 * TR_WI;
    if (r < 8 * TR_WO) { const int e = r / TR_WO; return tr_mk(P.moe_wo + (size_t)e * 3584 * 1024, 3584, 1024, (bf16_t*)(ws + O_MWO) + (size_t)e * 1024 * 3584, 0, r % TR_WO); } r -= 8 * TR_WO;
    if (r < TR_WI) return tr_mk(P.ffn_wi, 1024, 7168, (bf16_t*)(ws + O_FWI), 1, r); r -= TR_WI;
    if (r < TR_WO) return tr_mk(P.ffn_wo, 3584, 1024, (bf16_t*)(ws + O_FWO), 0, r); r -= TR_WO;
    if (r < TR_QKV) return tr_mk(P.wqkv, 1024, 1536, (bf16_t*)(ws + O_WQKV), 0, r); r -= TR_QKV;
    if (r < TR_AO) return tr_mk(P.attn_wo, 1024, 1024, (bf16_t*)(ws + O_WO), 0, r); r -= TR_AO;
    if (r < 2 * TR_FW) { const int j = r / TR_FW; return tr_mk(P.fnet_w + (size_t)j * 1024 * 1024, 1024, 1024, (bf16_t*)(ws + O_FWT) + (size_t)j * 1024 * 1024, 0, r % TR_FW); } r -= 2 * TR_FW;
    const int g = r / TR_PW; return tr_mk(P.pool_w + (size_t)g * 65536, 256, 256, (bf16_t*)(ws + O_POOLW) + (size_t)g * 65536, 0, r % TR_PW);
}
__device__ __forceinline__ void tr_load(const TDesc& d, float (&v)[32], int lane) {
    const float* p = d.src + (size_t)(lane >> 5) * d.N + (lane & 31);
#pragma unroll
    for (int i = 0; i < 32; ++i) v[i] = __builtin_nontemporal_load(p + (size_t)(2 * i) * d.N);
}
__device__ __forceinline__ void tr_store(const TDesc& d, const float (&v)[32], LAS float* scr, int lane) {
#pragma unroll
    for (int i = 0; i < 32; ++i) scr[(2 * i + (lane >> 5)) * 33 + (lane & 31)] = v[i];
    asm volatile("s_waitcnt lgkmcnt(0)" ::: "memory");
    const int c = lane & 7;
#pragma unroll
    for (int j = 0; j < 4; ++j) { const int n = (lane >> 3) + 8 * j; const LAS float* s = scr + (8 * c) * 33 + n;
        u32x4 o; o.x = pk2(s[0 * 33], s[1 * 33]); o.y = pk2(s[2 * 33], s[3 * 33]); o.z = pk2(s[4 * 33], s[5 * 33]); o.w = pk2(s[6 * 33], s[7 * 33]);
        *(u32x4*)(d.dst + (size_t)n * d.K + 8 * c) = o; }
    asm volatile("s_waitcnt lgkmcnt(0)" ::: "memory");
}

__device__ __forceinline__ void prep_phase(const Params& P, LAS unsigned char* lds) {
    const int tid = get_tid(), wave = tid >> 6, lane = tid & 63;
    unsigned char* ws = P.ws;
    const int gtid = get_bid() * NTHR + tid, gthreads = gridDim.x * NTHR;
    if (gtid < 16) ((int*)(ws + O_CTL))[gtid * CSTR] = 0;
    for (int t = gtid; t < 16384; t += gthreads) { float s, c; sincospif((float)t * (1.f / 8192.f), &s, &c); ((float2*)(ws + O_TW))[t] = make_float2(c, s); }
    for (int t = gtid; t < 256 * 16; t += gthreads) { const int pos = t >> 4, i = t & 15; const float inv = powf(10000.f, -(float)(2 * i) / 32.f); float s, c; sincosf((float)pos * inv, &s, &c); ((float2*)(ws + O_ROPE))[t] = make_float2(c, s); }
    for (int t = gtid; t < 256 * 256; t += gthreads) {
        const int r = t >> 8, cc = t & 255, cp = r >> 7, k = r & 127, c = cc >> 7, l = cc & 127; float s, co; sincospif((float)((k * l) & 127) * (1.f / 64.f), &s, &co);
        const float v1 = (cp == c) ? co : (cp == 0 ? s : -s);
        ((bf16_t*)(ws + O_FM1))[t] = (bf16_t)(pk2(v1, 0.f) & 0xFFFF);
        const float v2 = (cp == 0) ? (c == 0 ? co : s) : 0.f;
        ((bf16_t*)(ws + O_FM2))[t] = (bf16_t)(pk2(v2, 0.f) & 0xFFFF);
    }
    for (int t = gtid; t < 256 * 512; t += gthreads) {
        const int k = t >> 9, cc = t & 511, c = cc >> 8, l = cc & 255; float s, co; sincospif((float)((k * l) & 255) * (1.f / 128.f), &s, &co);
        ((bf16_t*)(ws + O_FC))[t] = (bf16_t)(pk2(c == 0 ? co : s, 0.f) & 0xFFFF);
    }
    for (int t = gtid; t < 512 * 256; t += gthreads) {
        const int r = t >> 8, mp = t & 255, c = r >> 8, ch = r & 255; float sn, co; sincospif((float)((ch * mp) & 255) * (1.f / 128.f), &sn, &co);
        ((bf16_t*)(ws + O_TMAT))[t] = (bf16_t)(pk2(c == 0 ? co : -sn, 0.f) & 0xFFFF);
    }
    { const f32x4* cs = (const f32x4*)P.ctx; f32x4* xd = (f32x4*)(ws + O_XRES);
      for (int t = gtid; t < CTXL * 256; t += gthreads) xd[SEQ * 256 + t] = cs[t]; }
    {
        LAS float* sc = (LAS float*)lds;
        LAS float* red = (LAS float*)(lds + 8192);
        for (int t = tid; t < 1024; t += NTHR) { sc[t] = silu_f(P.c[t]); sc[1024 + t] = silu_f(P.c_ctx[t]); }
        __syncthreads();
        for (int it = get_bid(); it < 192; it += gridDim.x) {
            const int i = it / 48, q = it % 48, col = 128 * q + 2 * lane;
            const float* wp = P.ada_w + (size_t)i * 1024 * 6144 + col;
            f32x2 a0 = {0, 0}, a1 = {0, 0};
#pragma unroll 16
            for (int kk = 0; kk < 128; ++kk) { const int k = wave * 128 + kk; const f32x2 w = *(const f32x2*)(wp + (size_t)k * 6144); a0 += sc[k] * w; a1 += sc[1024 + k] * w; }
            LAS float* rp = red + (wave * 64 + lane) * 4;
            rp[0] = a0[0]; rp[1] = a0[1]; rp[2] = a1[0]; rp[3] = a1[1];
            __syncthreads();
            if (wave == 0) {
                float s[4] = {0.f, 0.f, 0.f, 0.f};
#pragma unroll
                for (int w = 0; w < 8; ++w)
#pragma unroll
                    for (int e = 0; e < 4; ++e) s[e] += red[(w * 64 + lane) * 4 + e];
                const f32x2 bb = *(const f32x2*)(P.ada_b + i * 6144 + col);
                float* o0 = (float*)(ws + O_ADA) + (size_t)(i * 2 + 0) * 6144 + col; float* o1 = (float*)(ws + O_ADA) + (size_t)(i * 2 + 1) * 6144 + col;
                *(f32x2*)o0 = (f32x2){s[0] + bb[0], s[1] + bb[1]};
                *(f32x2*)o1 = (f32x2){s[2] + bb[0], s[3] + bb[1]};
            }
            __syncthreads();
        }
    }
    __syncthreads();
    {
        LAS float* scr = (LAS float*)(lds + wave * 8448);
        const int gw = get_bid() * NWAVE + wave, ngw = gridDim.x * NWAVE;
        int it = gw;
        float v[32]; TDesc cur;
        if (it < TR_NIT) { cur = tr_decode(P, ws, it, 0); tr_load(cur, v, lane); }
        while (it < TR_NIT) {
            const int nit = it + ngw; float w[32]; TDesc nx = cur;
            if (nit < TR_NIT) { nx = tr_decode(P, ws, nit, 0); tr_load(nx, w, lane); }
            tr_store(cur, v, scr, lane);
#pragma unroll
            for (int i = 0; i < 32; ++i) v[i] = w[i];
            cur = nx; it = nit;
        }
    }
}

__device__ __forceinline__ void deferred_work(const Params& P, LAS unsigned char* lds, int maxclaims, int units, int limit_items) {
    const int tid = get_tid(), wave = tid >> 6, lane = tid & 63;
    unsigned char* ws = P.ws;
    LAS float* scr = (LAS float*)(lds + wave * 8448); volatile LAS int* sc = (volatile LAS int*)(lds + 8 * 8448);
    unsigned* ctr = (unsigned*)(ws + O_BAR) + 3600;
    for (int n = 0; n < maxclaims; ++n) {
        __syncthreads();
        if (tid == 0) { int c = -1; const unsigned cur = __hip_atomic_load(ctr, __ATOMIC_RELAXED, __HIP_MEMORY_SCOPE_AGENT);
            const int stop = limit_items > 0 ? limit_items : TR_DEF;
            if ((int)cur * DCH < stop) c = (int)atomicAdd(ctr, (unsigned)units);
            *sc = c; }
        __syncthreads();
        const int c = *sc, base = c * DCH;
        if (c < 0 || base >= TR_DEF) break;
        const int cend = base + units * DCH, i1 = cend < TR_DEF ? cend : TR_DEF;
        int it = base + wave;
        float v[32]; TDesc cur;
        if (it < i1) { cur = tr_decode(P, ws, it, 1); tr_load(cur, v, lane); }
        while (it < i1) {
            const int nit = it + NWAVE; float w[32]; TDesc nx = cur;
            if (nit < i1) { nx = tr_decode(P, ws, nit, 1); tr_load(nx, w, lane); }
            tr_store(cur, v, scr, lane);
#pragma unroll
            for (int i = 0; i < 32; ++i) v[i] = w[i];
            cur = nx; it = nit;
        }
    }
    __syncthreads();
}

__device__ __forceinline__ void norm_phase(const Params& P, LAS unsigned char* lds, int layer, int which, int nrows, int flags, int fprev, int fnext, const float* g2ovr, const float* xsrc, const float* gcp) {
    const int tid = get_tid(), wave = tid >> 6, lane = tid & 63;
    unsigned char* ws = P.ws;
    float* xres = (float*)(ws + O_XRES);
    bf16_t* hbuf = (bf16_t*)(ws + O_HBUF);
    const float* ada = (const float*)(ws + O_ADA);
    const int gw = get_bid() * NWAVE + wave, ngw = gridDim.x * NWAVE;
    LAS float* rt = (LAS float*)lds;
    LAS int* etab = (LAS int*)(lds + 49152);
    LAS int* rtab = (LAS int*)(lds + 49152 + 8192);
    if (flags & 2) { const float* rp = P.router + (size_t)fnext * 1024 * 8;
        for (int t = tid; t < 1024; t += NTHR) { const int qq = t >> 6, ln = t & 63, col = 4 * ln + 256 * (qq >> 2) + (qq & 3);
            const f32x4 a = *(const f32x4*)(rp + col * 8), b = *(const f32x4*)(rp + col * 8 + 4); LAS f32x4* d = (LAS f32x4*)(rt + (qq * 64 + ln) * 12); d[0] = a; d[1] = b; }
        for (int t = tid; t < 2048; t += NTHR) etab[t] = -1; __syncthreads(); }
    const float* g2p = nullptr;
    if (flags & 4) {
        g2p = g2ovr ? g2ovr : ada + (size_t)((layer - 1) * 2 + 0) * 6144 + 5 * 1024;
    }
    const float2* rw = (const float2*)(ws + O_RW);
    const bf16_t* ysb = (const bf16_t*)(ws + O_YS); const float* ysp = (const float*)(ws + O_YSP);
    auto ldy = [&](int rowi, int j, int thr) -> f32x4 {
        if (rowi < thr) { const u32x2 raw = *((const u32x2*)(ysb + (size_t)rowi * D + 256 * j) + lane); return (f32x4){bflo(raw.x), bfhi(raw.x), bflo(raw.y), bfhi(raw.y)}; }
        f32x4 t[KSPL];
#pragma unroll
        for (int ks = 0; ks < KSPL; ++ks) t[ks] = *((const f32x4*)(ysp + ((size_t)ks * 2048 + (rowi - 32768)) * D + 256 * j) + lane);
        f32x4 a = t[0];
#pragma unroll
        for (int ks = 1; ks < KSPL; ++ks) a += t[ks];
        return a; };
    for (int pass = 0; pass < 2; ++pass) {
        const int rlo = pass == 0 ? 0 : SEQ, rhi = pass == 0 ? (nrows < SEQ ? nrows : SEQ) : nrows;
        if (rlo >= rhi || (pass == 0 && (flags & 32))) continue;
        f32x4 ga[4], sh[4], g2[4];
        if (!(flags & 8)) {
            const float* gain = (which == 0 ? P.norm_mix : P.norm_ffn) + layer * 1024;
            const float* ap = ada + (size_t)(layer * 2 + pass) * 6144 + (which == 0 ? 0 : 3 * 1024);
#pragma unroll
            for (int j = 0; j < 4; ++j) { const int col = 4 * lane + 256 * j; ga[j] = *(const f32x4*)(gain + col) * (1.f + *(const f32x4*)(ap + 1024 + col)); sh[j] = *(const f32x4*)(ap + col); }
        }
        if (flags & 4) {
#pragma unroll
            for (int j = 0; j < 4; ++j) g2[j] = *(const f32x4*)(g2p + 4 * lane + 256 * j);
        }
        int2 nsr = make_int2(0, 0); float2 nw = make_float2(0.f, 0.f);
        if ((flags & 4) && rlo + gw < rhi) { nsr = ((const int2*)(ws + O_SROW))[rlo + gw]; nw = rw[rlo + gw]; }
        for (int r = rlo + gw; r < rhi; r += ngw) {
            f32x4 v[4];
            const f32x4* xr = (const f32x4*)((r < SEQ ? xsrc : xres) + (size_t)r * D) + lane;
#pragma unroll
            for (int j = 0; j < 4; ++j) v[j] = xr[64 * j];
            if (flags & 4) {
                const int2 sr = nsr; const float2 w = nw;
                if (r + ngw < rhi) { nsr = ((const int2*)(ws + O_SROW))[r + ngw]; nw = rw[r + ngw]; }
                const int r0 = sr.x, r1 = sr.y;
#pragma unroll
                for (int j = 0; j < 4; ++j) v[j] = v[j] + g2[j] * (w.x * ldy(r0, j, MOE_SPLIT ? 32768 : (1 << 30)) + w.y * ldy(r1, j, MOE_SPLIT ? 32768 : (1 << 30)));
                f32x4* xo = (f32x4*)(((flags & 8) ? P.out : xres) + (size_t)r * D) + lane;
#pragma unroll
                for (int j = 0; j < 4; ++j) xo[64 * j] = v[j];
            }
            if ((flags & 16) && r >= SEQ) {
#pragma unroll
                for (int j = 0; j < 4; ++j) v[j] = v[j] + *(const f32x4*)(gcp + 4 * lane + 256 * j) * ldy(32768 + r - SEQ, j, 32768);
                f32x4* xo = (f32x4*)(xres + (size_t)r * D) + lane;
#pragma unroll
                for (int j = 0; j < 4; ++j) xo[64 * j] = v[j];
            }
            if (flags & 8) continue;
            float ss = 0.f;
#pragma unroll
            for (int j = 0; j < 4; ++j) ss += (v[j][0] * v[j][0] + v[j][1] * v[j][1]) + (v[j][2] * v[j][2] + v[j][3] * v[j][3]);
            const float rstd = rsqrtf(wave_sum(ss) * (1.f / D) + 1e-6f);
#pragma unroll
            for (int j = 0; j < 4; ++j) v[j] = v[j] * rstd * ga[j] + sh[j];
            int orow = r;
            if ((flags & 1) && r < SEQ) orow = 128 * (r & 127) + (r >> 7);
            u32x2* o8 = (u32x2*)(hbuf + (size_t)orow * D) + lane;
#pragma unroll
            for (int j = 0; j < 4; ++j) { u32x2 o; o.x = pk2(v[j][0], v[j][1]); o.y = pk2(v[j][2], v[j][3]); o8[64 * j] = o; }
            if (flags & 2) {
                float lg[8];
#pragma unroll
                for (int e = 0; e < 8; ++e) lg[e] = 0.f;
#pragma unroll
                for (int j = 0; j < 4; ++j)
#pragma unroll
                    for (int e = 0; e < 4; ++e) { const LAS f32x4* rr = (const LAS f32x4*)(rt + ((j * 4 + e) * 64 + lane) * 12); const f32x4 r0 = rr[0], r1 = rr[1]; const float hv = v[j][e];
                        lg[0] += hv * r0[0]; lg[1] += hv * r0[1]; lg[2] += hv * r0[2]; lg[3] += hv * r0[3]; lg[4] += hv * r1[0]; lg[5] += hv * r1[1]; lg[6] += hv * r1[2]; lg[7] += hv * r1[3]; }
#pragma unroll
                for (int e = 0; e < 8; ++e) lg[e] = wave_sum(lg[e]);
                int e0 = 0; float v0 = lg[0];
#pragma unroll
                for (int e = 1; e < 8; ++e) if (lg[e] > v0) { v0 = lg[e]; e0 = e; }
                int e1 = -1; float v1 = -3.0e38f;
#pragma unroll
                for (int e = 0; e < 8; ++e) if (e != e0 && lg[e] > v1) { v1 = lg[e]; e1 = e; }
                if (lane == 0) {
                    const int rho = ((r - gw) / ngw) * NWAVE + wave;
                    etab[2 * rho] = e0; etab[2 * rho + 1] = e1;
                    const float ex = __expf(v1 - v0), w0 = 1.f / (1.f + ex);
                    ((float2*)(ws + O_RW))[r] = make_float2(w0, ex * w0);
                }
            }
        }
    }
    if (flags & 2) {
        __syncthreads();
        const int nent = 2 * NWAVE * ((SEQ + ngw - 1) / ngw);
        if (wave == 0) {
            int run[NEXP];
#pragma unroll
            for (int e = 0; e < NEXP; ++e) run[e] = 0;
            for (int base = 0; base < nent; base += 64) {
                const int i = base + lane, ee = etab[i]; int myrank = 0;
#pragma unroll
                for (int e = 0; e < NEXP; ++e) { const unsigned long long mask = __ballot(ee == e); if (ee == e) myrank = run[e] + __popcll(mask & ((1ull << lane) - 1ull)); run[e] += __popcll(mask); }
                rtab[i] = myrank;
            }
            int mine = 0;
#pragma unroll
            for (int e = 0; e < NEXP; ++e) if (lane == e) mine = run[e];
            if (lane < NEXP) ((int*)(ws + O_BLK))[get_bid() * NEXP + lane] = mine;
        }
        __syncthreads();
        if (lane == 0) {
            int4* route_w = (int4*)(ws + O_ROUTE);
            for (int r = gw; r < SEQ; r += ngw) { const int rho = ((r - gw) / ngw) * NWAVE + wave; route_w[r] = make_int4(etab[2 * rho], rtab[2 * rho], etab[2 * rho + 1], rtab[2 * rho + 1]); }
        }
        __syncthreads();
    }
}

__device__ __forceinline__ void gather_phase(const Params& P, LAS unsigned char* lds, int f) {
    const int tid = get_tid(), wave = tid >> 6, lane = tid & 63;
    unsigned char* ws = P.ws;
    const int gw = get_bid() * NWAVE + wave, ngw = gridDim.x * NWAVE, nb = gridDim.x;
    LAS int* pre = (LAS int*)lds;
    LAS int* tot = (LAS int*)(lds + 32768);
    const int* blk = (const int*)(ws + O_BLK);
    __syncthreads();
    for (int t = tid; t < nb * NEXP; t += NTHR) pre[t] = blk[t];
    __syncthreads();
    {
        const int e = wave; int c[4], sum = 0;
#pragma unroll
        for (int j = 0; j < 4; ++j) { const int b = 4 * lane + j; c[j] = (b < nb) ? pre[b * NEXP + e] : 0; sum += c[j]; }
        int incl = sum;
#pragma unroll
        for (int o = 1; o < 64; o <<= 1) { const int t = __shfl_up(incl, o); if (lane >= o) incl += t; }
        int run = incl - sum; const int total = __shfl(incl, 63);
#pragma unroll
        for (int j = 0; j < 4; ++j) { const int b = 4 * lane + j; if (b < nb) { pre[b * NEXP + e] = run; run += c[j]; } }
        if (lane == 0) { tot[e] = total; if (get_bid() == 0) ((int*)(ws + O_CTL))[(f * 8 + e) * CSTR] = total; }
    }
    __syncthreads();
    int off[NEXP], cn[NEXP]; { int a = 0;
#pragma unroll
        for (int e = 0; e < NEXP; ++e) { cn[e] = tot[e]; off[e] = a; a += ((cn[e] + 255) >> 8) << 8; } }
    const int4* route = (const int4*)(ws + O_ROUTE);
    int* inv = (int*)(ws + O_INV);
    for (int t = get_bid() * NTHR + tid; t < SEQ; t += nb * NTHR) {
        const int4 ro = route[t]; const int b = (t % ngw) / NWAVE;
        int r0 = pre[b * NEXP + ro.x] + ro.y, r1 = pre[b * NEXP + ro.z] + ro.w;
#pragma unroll
        for (int e = 0; e < NEXP; ++e) { if (ro.x == e) r0 += off[e]; if (ro.z == e) r1 += off[e]; }
        ((int2*)(ws + O_SROW))[t] = make_int2(r0, r1);
        inv[r0] = t; inv[r1] = t;
    }
#pragma unroll
    for (int e = 0; e < NEXP; ++e) {
        const int lo = off[e] + cn[e], hi = off[e] + (((cn[e] + 255) >> 8) << 8);
        for (int r = lo + get_bid() * NTHR + tid; r < hi; r += nb * NTHR) inv[r] = 0;
    }
    __syncthreads();
}

__device__ __forceinline__ void qkpost_phase(const Params& P) {
    const int tid = get_tid(), wave = tid >> 6, lane = tid & 63;
    unsigned char* ws = P.ws;
    const int gw = get_bid() * NWAVE + wave, ngw = gridDim.x * NWAVE;
    bf16_t* qk = (bf16_t*)(ws + O_QK); const float2* rope = (const float2*)(ws + O_ROPE);
    const int sub = lane & 15, d0 = 4 * sub;
    const f32x4 gq = *(const f32x4*)(P.q_gain + d0), gk = *(const f32x4*)(P.k_gain + d0);
    for (int r = gw; r < MTOT; r += ngw) {
        const int pos = (sub < 8) ? (r >> 6) : (r & 63);
        float2 cs[4];
#pragma unroll
        for (int e = 0; e < 4; ++e) cs[e] = rope[(pos & 255) * 16 + 4 * (sub & 3) + e];
#pragma unroll
        for (int p = 0; p < 5; ++p) {
            const int hh = 4 * p + (lane >> 4); const bool isq = hh < 16;
            u32x2* ptr = (u32x2*)(qk + (size_t)r * 1280 + hh * 64 + d0);
            const u32x2 raw = *ptr;
            float y[4] = {bflo(raw.x), bfhi(raw.x), bflo(raw.y), bfhi(raw.y)};
            float ss = (y[0] * y[0] + y[1] * y[1]) + (y[2] * y[2] + y[3] * y[3]);
            ss += __shfl_xor(ss, 1); ss += __shfl_xor(ss, 2); ss += __shfl_xor(ss, 4); ss += __shfl_xor(ss, 8);
            const float rs = rsqrtf(ss * (1.f / 64.f) + 1e-6f) * (isq ? 0.125f : 1.f);
            const f32x4 g = isq ? gq : gk;
#pragma unroll
            for (int e = 0; e < 4; ++e) y[e] = y[e] * rs * g[e];
            float py[4];
#pragma unroll
            for (int e = 0; e < 4; ++e) py[e] = __shfl_xor(y[e], 4);
            if (r < SEQ) {
#pragma unroll
                for (int e = 0; e < 4; ++e) y[e] = (sub & 4) ? (py[e] * cs[e].y + y[e] * cs[e].x) : (y[e] * cs[e].x - py[e] * cs[e].y);
            }
            if (r < SEQ || !isq) { u32x2 o; o.x = pk2(y[0], y[1]); o.y = pk2(y[2], y[3]); *ptr = o; }
        }
    }
}

__device__ __forceinline__ void attn_chunk(LAS unsigned char* Kl, LAS unsigned char* Vl, const bf16x8 (&qf)[4], f32x16 (&o)[2], float& m, float& l, int q, int half, int ii, int maskmode) {
    f32x16 s[2];
#pragma unroll
    for (int kb = 0; kb < 2; ++kb) {
#pragma unroll
        for (int r = 0; r < 16; ++r) s[kb][r] = 0.f;
#pragma unroll
        for (int ks = 0; ks < 4; ++ks) { const bf16x8 kf = *(const LAS bf16x8*)(Kl + (32 * kb + q) * 144 + (2 * ks + half) * 16); s[kb] = __builtin_amdgcn_mfma_f32_32x32x16_bf16(kf, qf[ks], s[kb], 0, 0, 0); }
    }
    if (maskmode != 0) {
#pragma unroll
        for (int kb = 0; kb < 2; ++kb)
#pragma unroll
            for (int r = 0; r < 16; ++r) { const int jj = 32 * kb + 8 * (r >> 2) + 4 * half + (r & 3); const bool ok = (maskmode == 1) ? (jj >= ii) : (jj <= ii); if (!ok) s[kb][r] = -1e30f; }
    }
    float mx = s[0][0];
#pragma unroll
    for (int kb = 0; kb < 2; ++kb)
#pragma unroll
        for (int r = 0; r < 16; ++r) mx = fmaxf(mx, s[kb][r]);
    mx = fmaxf(mx, __shfl_xor(mx, 32));
    const float mn = fmaxf(m, mx), alpha = __expf(m - mn);
    float ps = 0.f;
#pragma unroll
    for (int kb = 0; kb < 2; ++kb)
#pragma unroll
        for (int r = 0; r < 16; ++r) { const float p = __expf(s[kb][r] - mn); s[kb][r] = p; ps += p; }
    l = l * alpha + ps; m = mn;
#pragma unroll
    for (int db = 0; db < 2; ++db)
#pragma unroll
        for (int r = 0; r < 16; ++r) o[db][r] *= alpha;
#pragma unroll
    for (int kb = 0; kb < 2; ++kb)
#pragma unroll
        for (int t = 0; t < 2; ++t) {
            union { bf16x8 v; unsigned u[4]; } pf;
#pragma unroll
            for (int i = 0; i < 4; ++i) pf.u[i] = pk2(s[kb][8 * t + 2 * i], s[kb][8 * t + 2 * i + 1]);
#pragma unroll
            for (int db = 0; db < 2; ++db) {
                union { bf16x8 v; u32x2 h[2]; } vf;
                const LAS unsigned char* vp = Vl + (32 * db + q) * 136 + (32 * kb + 16 * t + 4 * half) * 2;
                vf.h[0] = *(const LAS u32x2*)vp; vf.h[1] = *(const LAS u32x2*)(vp + 16);
                o[db] = __builtin_amdgcn_mfma_f32_32x32x16_bf16(vf.v, pf.v, o[db], 0, 0, 0);
            }
        }
}
__device__ __forceinline__ void attn_stage(LAS unsigned char* Kl, LAS unsigned char* Vl, const bf16_t* qk, const bf16_t* Vt, int tok0, int g, int tid, const float* kgain, const float2* rope, bool do_rope) {
    const int row = tid >> 3, piece = tid & 7;
    const u32x4 kraw = *(const u32x4*)(qk + (size_t)(tok0 + row) * 1280 + 1024 + 64 * g + 8 * piece);
    float y[8] = {bflo(kraw.x), bfhi(kraw.x), bflo(kraw.y), bfhi(kraw.y), bflo(kraw.z), bfhi(kraw.z), bflo(kraw.w), bfhi(kraw.w)};
    float ss = 0.f;
#pragma unroll
    for (int i = 0; i < 8; ++i) ss += y[i] * y[i];
    ss += __shfl_xor(ss, 1); ss += __shfl_xor(ss, 2); ss += __shfl_xor(ss, 4);
    const float rs = rsqrtf(ss * (1.f / 64.f) + 1e-6f);
    const f32x4 g0 = *(const f32x4*)(kgain + 8 * piece), g1 = *(const f32x4*)(kgain + 8 * piece + 4);
#pragma unroll
    for (int i = 0; i < 4; ++i) { y[i] *= rs * g0[i]; y[4 + i] *= rs * g1[i]; }
    float py[8];
#pragma unroll
    for (int i = 0; i < 8; ++i) py[i] = __shfl_xor(y[i], 2);
    if (do_rope) {
        const int token = tok0 + row, pos = (piece < 4) ? (token >> 6) : (token & 63);
        const float2* cs = rope + pos * 16 + 8 * (piece & 1);
#pragma unroll
        for (int i = 0; i < 8; ++i) { const float2 t = cs[i]; y[i] = (piece & 2) ? (py[i] * t.y + y[i] * t.x) : (y[i] * t.x - py[i] * t.y); }
    }
    u32x4 kv; kv.x = pk2(y[0], y[1]); kv.y = pk2(y[2], y[3]); kv.z = pk2(y[4], y[5]); kv.w = pk2(y[6], y[7]);
    *(LAS u32x4*)(Kl + row * 144 + piece * 16) = kv;
    const u32x4 vv = *(const u32x4*)(Vt + (size_t)(g * 64 + row) * MTOT + tok0 + 8 * piece);
    LAS u32x2* vd = (LAS u32x2*)(Vl + row * 136 + piece * 16); vd[0] = (u32x2){vv.x, vv.y}; vd[1] = (u32x2){vv.z, vv.w};
}
__device__ __forceinline__ void attn_phase(const Params& P, LAS unsigned char* lds) {
    const int tid = get_tid(), wave = tid >> 6, lane = tid & 63, q = lane & 31, half = lane >> 5;
    unsigned char* ws = P.ws;
    const bf16_t* qk = (const bf16_t*)(ws + O_QK); const bf16_t* Vt = (const bf16_t*)(ws + O_VT); bf16_t* ao = (bf16_t*)(ws + O_AO);
    const float2* rope = (const float2*)(ws + O_ROPE);
    constexpr int KSZ = 64 * 144, VSZ = 64 * 136, VBASE = 5 * KSZ;
    for (int unit = get_bid(); unit < 1024; unit += gridDim.x) {
        const int qb = unit >> 2, g = unit & 3, h = 4 * g + (wave >> 1), ii = 32 * (wave & 1) + q, tok = 64 * qb + ii;
        bf16x8 qf[4];
        {
            float yq[4][8]; float ss = 0.f;
#pragma unroll
            for (int ks = 0; ks < 4; ++ks) { const u32x4 raw = *(const u32x4*)(qk + (size_t)tok * 1280 + h * 64 + 16 * ks + 8 * half);
                yq[ks][0] = bflo(raw.x); yq[ks][1] = bfhi(raw.x); yq[ks][2] = bflo(raw.y); yq[ks][3] = bfhi(raw.y); yq[ks][4] = bflo(raw.z); yq[ks][5] = bfhi(raw.z); yq[ks][6] = bflo(raw.w); yq[ks][7] = bfhi(raw.w);
#pragma unroll
                for (int i = 0; i < 8; ++i) ss += yq[ks][i] * yq[ks][i]; }
            ss += __shfl_xor(ss, 32);
            const float rs = rsqrtf(ss * (1.f / 64.f) + 1e-6f) * 0.125f;
#pragma unroll
            for (int ks = 0; ks < 4; ++ks) { const f32x4 g0 = *(const f32x4*)(P.q_gain + 16 * ks + 8 * half), g1 = *(const f32x4*)(P.q_gain + 16 * ks + 8 * half + 4);
#pragma unroll
                for (int i = 0; i < 4; ++i) { yq[ks][i] *= rs * g0[i]; yq[ks][4 + i] *= rs * g1[i]; } }
            const float2* cr = rope + (tok >> 6) * 16 + 8 * half; const float2* cc = rope + (tok & 63) * 16 + 8 * half;
#pragma unroll
            for (int i = 0; i < 8; ++i) { const float2 tr = cr[i], tc = cc[i];
                const float a1 = yq[0][i], a2 = yq[1][i]; yq[0][i] = a1 * tr.x - a2 * tr.y; yq[1][i] = a1 * tr.y + a2 * tr.x;
                const float b1 = yq[2][i], b2 = yq[3][i]; yq[2][i] = b1 * tc.x - b2 * tc.y; yq[3][i] = b1 * tc.y + b2 * tc.x; }
#pragma unroll
            for (int ks = 0; ks < 4; ++ks) { union { bf16x8 v; unsigned u[4]; } pk;
#pragma unroll
                for (int i = 0; i < 4; ++i) pk.u[i] = pk2(yq[ks][2 * i], yq[ks][2 * i + 1]);
                qf[ks] = pk.v; }
        }
        float m = P.sink[h], l = (half == 0) ? 1.f : 0.f;
        f32x16 o[2];
#pragma unroll
        for (int db = 0; db < 2; ++db)
#pragma unroll
            for (int r = 0; r < 16; ++r) o[db][r] = 0.f;
#pragma unroll
        for (int ci = 0; ci < 5; ++ci) { const int cb = qb - 2 + ci; if (cb >= 0 && cb < SEQ / 64) attn_stage(lds + ci * KSZ, lds + VBASE + ci * VSZ, qk, Vt, 64 * cb, g, tid, P.k_gain, rope, true); }
        __syncthreads();
#pragma unroll
        for (int ci = 0; ci < 5; ++ci) { const int cb = qb - 2 + ci; if (cb >= 0 && cb < SEQ / 64) attn_chunk(lds + ci * KSZ, lds + VBASE + ci * VSZ, qf, o, m, l, q, half, ii, ci == 0 ? 1 : (ci == 4 ? 2 : 0)); }
        __syncthreads();
#pragma unroll
        for (int ci = 0; ci < 4; ++ci) attn_stage(lds + ci * KSZ, lds + VBASE + ci * VSZ, qk, Vt, SEQ + 64 * ci, g, tid, P.k_gain, rope, false);
        __syncthreads();
#pragma unroll
        for (int ci = 0; ci < 4; ++ci) attn_chunk(lds + ci * KSZ, lds + VBASE + ci * VSZ, qf, o, m, l, q, half, ii, 0);
        __syncthreads();
        const float lt = l + __shfl_xor(l, 32), inv = 1.f / lt;
        bf16_t* op = ao + (size_t)tok * D + h * 64;
#pragma unroll
        for (int db = 0; db < 2; ++db)
#pragma unroll
            for (int rg = 0; rg < 4; ++rg) { u32x2 ov; ov.x = pk2(o[db][4 * rg] * inv, o[db][4 * rg + 1] * inv); ov.y = pk2(o[db][4 * rg + 2] * inv, o[db][4 * rg + 3] * inv);
                *(u32x2*)(op + 32 * db + 8 * rg + 4 * half) = ov; }
    }
}

template <int J> __device__ __forceinline__ void pool_group(const bf16_t* hbuf, bf16_t* pl, int c0, int lane) {
    constexpr int W = 2 << J, H = W >> 1, NR = 8 + W - 1;
    u32x2 raw[NR];
#pragma unroll
    for (int k = 0; k < NR; ++k) { const int tt = c0 - H + k; const bool ok = tt >= 0 && tt < SEQ; const int tc = ok ? tt : c0;
        raw[k] = *((const u32x2*)(hbuf + (size_t)tc * D + 256 * J) + lane); if (!ok) raw[k] = (u32x2){0u, 0u}; }
    float s0 = 0.f, s1 = 0.f, s2 = 0.f, s3 = 0.f;
#pragma unroll
    for (int k = 0; k < W; ++k) { s0 += bflo(raw[k].x); s1 += bfhi(raw[k].x); s2 += bflo(raw[k].y); s3 += bfhi(raw[k].y); }
#pragma unroll
    for (int i = 0; i < 8; ++i) {
        const int t = c0 + i; int lo = t - H, hi = t + H - 1; lo = lo < 0 ? 0 : lo; hi = hi > SEQ - 1 ? SEQ - 1 : hi;
        const float ic = 1.f / (float)(hi - lo + 1);
        const u32x2 self = raw[i + H];
        u32x2 o; o.x = pk2(s0 * ic - bflo(self.x), s1 * ic - bfhi(self.x)); o.y = pk2(s2 * ic - bflo(self.y), s3 * ic - bfhi(self.y));
        *((u32x2*)(pl + ((size_t)J * SEQ + t) * 256) + lane) = o;
        if (i < 7) { s0 += bflo(raw[i + W].x) - bflo(raw[i].x); s1 += bfhi(raw[i + W].x) - bfhi(raw[i].x); s2 += bflo(raw[i + W].y) - bflo(raw[i].y); s3 += bfhi(raw[i + W].y) - bfhi(raw[i].y); }
    }
}
__device__ __forceinline__ void pool_phase(const Params& P) {
    const int tid = get_tid(), wave = tid >> 6, lane = tid & 63;
    unsigned char* ws = P.ws;
    const int gw = get_bid() * NWAVE + wave, ngw = gridDim.x * NWAVE;
    const bf16_t* hbuf = (const bf16_t*)(ws + O_HBUF); bf16_t* pl = (bf16_t*)(ws + O_POOL);
    for (int c0 = gw * 8; c0 < SEQ; c0 += ngw * 8) {
        pool_group<0>(hbuf, pl, c0, lane); pool_group<1>(hbuf, pl, c0, lane); pool_group<2>(hbuf, pl, c0, lane); pool_group<3>(hbuf, pl, c0, lane);
    }
}

enum { K_PREP, K_NORM, K_FGEMM, K_STEP1, K_STEP2, K_FFNWI, K_FFNWO, K_QKV, K_QKPOST, K_ATTN, K_ATTNWO, K_GATHER, K_MOEWI, K_MOEWO, K_POOL, K_POOLG, K_CTXDFT, K_FOLD, K_WOSPLIT, K_NONE };
constexpr int NPHASE = 32;

__global__ void __launch_bounds__(NTHR, 2) mega_fwd(Params P) {
    extern __shared__ __attribute__((aligned(16))) unsigned char smem[];
    LAS unsigned char* lds = (LAS unsigned char*)smem;
    unsigned char* ws = P.ws;
    const float* ada = (const float*)(ws + O_ADA);
    float* xres = (float*)(ws + O_XRES);
    volatile LAS unsigned* xst = (volatile LAS unsigned*)(lds + LDS_BYTES);
    if (threadIdx.x == 0) { xst[0] = 0u; xst[1] = 0u; }
    __syncthreads();
    const XcdBarrier xb = xcd_barrier_post((unsigned*)(ws + O_BAR), xst);
#ifndef REPEAT_MASK
#define REPEAT_MASK 0u
#endif

    for (int ph = P.ph_lo; ph < P.ph_hi; ++ph) {
      if (ph == 10) continue;
      if (ph == 20 || ph == 23) continue;
      const int nrep = ((REPEAT_MASK >> ph) & 1u) ? 2 : 1;
      for (int rep = 0; rep < nrep; ++rep) {
      if (rep > 0) xcd_barrier(xb);
      for (int sub = 0; sub < 2; ++sub) {
        if (rep > 0 && sub > 0) continue;
        int kind = K_NONE, layer = 0, a0 = 0, a1 = 0, a2 = 0, a3 = 0;
        if (sub == 0) {
        switch (ph) {
            case 0: kind = K_PREP; break;
            case 1: kind = K_NORM; layer = 0; a0 = 0; a1 = MTOT; a2 = 1; break;
            case 2: kind = K_FGEMM; layer = 0; a0 = 0; a1 = MTOT; break;
            case 3: kind = K_STEP1; layer = 0; break;
            case 4: kind = K_STEP2; layer = 0; break;
            case 5: kind = K_NORM; layer = 0; a0 = 1; a1 = MTOT; break;
            case 6: kind = K_FFNWI; a0 = 0; a1 = MTOT; break;
            case 7: kind = K_FFNWO; layer = 0; a0 = 0; a1 = SEQ; break;
            case 8: kind = K_NORM; layer = 1; a0 = 0; a1 = MTOT; a2 = 16 | 32; break;
            case 9: kind = K_QKV; break;
            case 10: kind = K_QKPOST; break;
            case 11: kind = K_ATTN; break;
            case 12: kind = K_ATTNWO; layer = 1; break;
            case 13: kind = K_NORM; layer = 1; a0 = 1; a1 = SEQ; a2 = 2; a3 = 0; break;
            case 14: kind = K_GATHER; a0 = 0; break;
            case 15: kind = K_MOEWI; a0 = 0; break;
            case 16: kind = K_MOEWO; a0 = 0; break;
            case 17: kind = K_NORM; layer = 2; a0 = 0; a1 = SEQ; a2 = 4; a3 = 0; break;
            case 18: kind = K_POOL; break;
            case 19: kind = K_POOLG; layer = 2; break;
            case 20: kind = K_NORM; layer = 2; a0 = 1; a1 = SEQ; break;
            case 21: kind = K_FFNWI; a0 = 1; a1 = SEQ; break;
            case 22: kind = K_FFNWO; layer = 2; a0 = 1; a1 = SEQ; break;
            case 23: kind = K_NORM; layer = 3; a0 = 0; a1 = SEQ; a2 = 1; break;
            case 24: kind = K_FGEMM; layer = 3; a0 = 1; a1 = SEQ; break;
            case 25: kind = K_STEP1; layer = 3; break;
            case 26: kind = K_STEP2; layer = 3; break;
            case 27: kind = K_NORM; layer = 3; a0 = 1; a1 = SEQ; a2 = 2; a3 = 1; break;
            case 28: kind = K_GATHER; a0 = 1; break;
            case 29: kind = K_MOEWI; a0 = 1; break;
            case 30: kind = K_MOEWO; a0 = 1; break;
            default: kind = K_NORM; layer = 4; a0 = 0; a1 = SEQ; a2 = 4 | 8; a3 = 1; break;
        }
        } else {
            if (ph == 1) { kind = K_FOLD; }
            else if (ph == 3) { kind = K_CTXDFT; layer = 0; }
            else if (ph == 9) { kind = K_QKV; a0 = 1; }
            else if (ph == 7) { kind = K_WOSPLIT; a0 = 0; a1 = 0; }
            else if (MOE_SPLIT && ph == 16) { kind = K_WOSPLIT; a0 = 0; a1 = 1; }
            else if (MOE_SPLIT && ph == 30) { kind = K_WOSPLIT; a0 = 1; a1 = 1; }
        }
        if (kind == K_NONE) continue;
        const float* zv = (const float*)(ws + O_ZERO);
        const int lyr = layer < 4 ? layer : 3;
        const float* gx1 = rep > 0 ? zv : ada + (size_t)(lyr * 2) * 6144 + 2 * 1024;
        const float* gx2 = rep > 0 ? zv : ada + (size_t)(lyr * 2) * 6144 + 5 * 1024;
        const float* gc1 = rep > 0 ? zv : ada + (size_t)(lyr * 2 + 1) * 6144 + 2 * 1024;
        const float* gc2 = rep > 0 ? zv : ada + (size_t)(lyr * 2 + 1) * 6144 + 5 * 1024;
#ifndef KIND_MASK
#define KIND_MASK 0xFFFFFF
#endif
#define KON(k) if (!((KIND_MASK >> (k)) & 1)) break;
        switch (kind) {
            case K_PREP: KON(K_PREP) prep_phase(P, lds); break;
            case K_NORM: KON(K_NORM) norm_phase(P, lds, layer, a0, a1, a2, a3, a3, rep > 0 ? zv : nullptr, (ph == 1) ? P.x : xres, rep > 0 ? zv : ada + (size_t)(0 * 2 + 1) * 6144 + 5 * 1024);
                break;
            case K_FGEMM: KON(K_FGEMM) { SchedGrid S; S.init(ws + O_WFT + (size_t)a0 * 2048 * 1024 * 2, ws + O_HBUF, 2048, a1, 1024);
                EpiFZ E{(bf16_t*)(ws + O_ZT), (bf16_t*)(ws + O_ZCT)}; gemm_phase(lds, 1024, 1024, 1024, S, E);
                if (DEFER && DEFER_HOOKS && rep == 0 && ph == 2 && get_bid() >= (S.nwg % (int)gridDim.x)) deferred_work(P, lds, 1, 3, 0); } break;
            case K_STEP1: KON(K_STEP1) { SchedGrid S; S.init(ws + O_FM1, ws + O_ZT, 256, 131072, 256);
                EpiStep1 E{(bf16_t*)(ws + O_YP), (const float2*)(ws + O_TW)}; gemm_phase(lds, 256, 256, 256, S, E); } break;
            case K_CTXDFT: KON(K_CTXDFT) { SchedGrid S2; S2.init(ws + O_FC, ws + O_ZCT, 256, 1024, 512);
                EpiCtxDft E2{xres, gc1}; gemm_phase(lds, 512, 512, 512, S2, E2); } break;
            case K_FOLD: KON(K_FOLD) { SchedFold S{(const char*)(ws + O_FWT), (const char*)(ws + O_TMAT)};
                EpiFold E{(bf16_t*)(ws + O_WFT)}; gemm_phase(lds, 256, 1024, 256, S, E); } break;
            case K_WOSPLIT: KON(K_WOSPLIT) { SchedSplit S; S.cnt = (const int*)(ws + O_CTL) + a0 * 8 * CSTR; S.moe = a1;
                if (a1) { int t = 0;
#pragma unroll
                    for (int e = 0; e < NEXP; ++e) t += (S.cnt[e * CSTR] + 255) >> 8;
                    S.tile0 = 128; S.ntile = t - 128; S.A = (const char*)(ws + O_HIDS); S.B = (const char*)(ws + O_MWO + (size_t)a0 * 8 * 1024 * 3584 * 2); S.estride = (size_t)1024 * 3584 * 2; }
                else { S.tile0 = 64; S.ntile = 1; S.A = (const char*)(ws + O_HID); S.B = (const char*)(ws + O_FWO); S.estride = 0; }
                EpiPartial E{(float*)(ws + O_YSP)}; gemm_phase(lds, KCH, DFF, DFF, S, E);
                if (DEFER && DEFER_HOOKS && rep == 0 && ph < 20 && get_bid() >= S.ntile * 4 * KSPL) deferred_work(P, lds, 1, 1, 0); } break;
            case K_STEP2: KON(K_STEP2) { SchedGrid S; S.init(ws + O_FM2, ws + O_YP, 256, 131072, 256);
                EpiStep2 E{xres, gx1, (ph == 4 && rep == 0) ? P.x : xres}; gemm_phase(lds, 256, 256, 256, S, E); } break;
            case K_FFNWI: KON(K_FFNWI) { SchedGrid S; S.init(ws + O_HBUF, ws + O_FWI + (size_t)a0 * 7168 * 1024 * 2, a1, 7168, 1024);
                EpiSwiglu E{(bf16_t*)(ws + O_HID)}; gemm_phase(lds, 1024, 1024, 1024, S, E);
                if (DEFER && DEFER_HOOKS && rep == 0 && ph == 6 && get_bid() >= (S.nwg % (int)gridDim.x)) deferred_work(P, lds, 1, 3, 0); } break;
            case K_FFNWO: KON(K_FFNWO) { SchedGrid S; S.init(ws + O_HID, ws + O_FWO + (size_t)a0 * 1024 * 3584 * 2, a1, 1024, 3584);
                const int nl = layer + 1;
                EpiResidNorm<false> E{xres, gx2, nullptr, P.norm_mix + nl * 1024, ada + (size_t)(nl * 2) * 6144, (bf16_t*)(ws + O_HBUF), (float*)(ws + O_PART),
                                      (unsigned*)(ws + O_ZERO + 4096) + (layer == 0 ? 0 : 1024), nl == 3 ? 1 : 0};
                gemm_phase(lds, 3584, 3584, 3584, S, E); } break;
            case K_QKV: KON(K_QKV) { SchedGrid S; EpiStoreBf16 E;
                if (a0 == 0) { S.init(ws + O_HBUF, ws + O_WQKV, MTOT, 1280, 1024); E.O = (bf16_t*)(ws + O_QK); E.ld = 1280; }
                else { S.init(ws + O_WQKV + (size_t)1280 * 1024 * 2, ws + O_HBUF, 256, MTOT, 1024); E.O = (bf16_t*)(ws + O_VT); E.ld = MTOT; S.boff = 128; }
                gemm_phase(lds, 1024, 1024, 1024, S, E);
                if (DEFER && DEFER_HOOKS && rep == 0 && a0 == 1) { const int b = get_bid(); if (b >= 69 && !(b >= 128 && b < 193)) deferred_work(P, lds, 1, 3, 0); } } break;
            case K_QKPOST: KON(K_QKPOST) qkpost_phase(P); break;
            case K_ATTN: KON(K_ATTN) attn_phase(P, lds); break;
            case K_ATTNWO: KON(K_ATTNWO) { SchedGrid S; S.init(ws + O_AO, ws + O_WO, SEQ, 1024, 1024);
                EpiResid E{xres, gx1, gc1}; gemm_phase(lds, 1024, 1024, 1024, S, E); } break;
            case K_GATHER: KON(K_GATHER) gather_phase(P, lds, a0); if (DEFER && rep == 0 && ph == 28) deferred_work(P, lds, 1 << 20, 8, TR_DEF); break;
            case K_MOEWI: KON(K_MOEWI) { SchedMoeT<true> S; S.inv = (const int*)(ws + O_INV); S.abase = (const char*)(ws + O_HBUF); S.init((const int*)(ws + O_CTL) + a0 * 8 * CSTR, ws + O_HBUF, ws + O_MWI + (size_t)a0 * 8 * 7168 * 1024 * 2, 7168, 1024, 0, 1 << 20);
                EpiSwiglu E{(bf16_t*)(ws + O_HIDS)}; gemm_phase(lds, 1024, 1024, 1024, S, E);
                if (DEFER && DEFER_HOOKS && rep == 0 && ph == 15) { const int rem = (S.T * S.nN) % (int)gridDim.x; if (rem != 0 && get_bid() >= rem) deferred_work(P, lds, 1, 3, 0); } } break;
            case K_MOEWO: KON(K_MOEWO) { SchedMoeT<false> S; S.init((const int*)(ws + O_CTL) + a0 * 8 * CSTR, ws + O_HIDS, ws + O_MWO + (size_t)a0 * 8 * 1024 * 3584 * 2, 1024, 3584, 1, MOE_SPLIT ? 128 : (1 << 20));
                EpiStoreBf16 E{(bf16_t*)(ws + O_YS), 1024}; gemm_phase(lds, 3584, 3584, 3584, S, E); } break;
            case K_POOL: KON(K_POOL) pool_phase(P); if (DEFER && rep == 0) deferred_work(P, lds, 1 << 20, 8, TR_DEF_DENSE); break;
            case K_POOLG: KON(K_POOLG) { SchedPool S{(const char*)(ws + O_POOL), (const char*)(ws + O_POOLW), (size_t)BM * 256 * 2};
                EpiResidNorm<true> E{xres, gx1, P.pool_scale, P.norm_ffn + layer * 1024, ada + (size_t)(layer * 2) * 6144 + 3 * 1024, (bf16_t*)(ws + O_HBUF), (float*)(ws + O_PART),
                                     (unsigned*)(ws + O_ZERO + 4096) + 2048, 0};
                gemm_phase(lds, 256, 256, 256, S, E); } break;
        }
      }
      }
        if (ph + 1 < P.ph_hi) { if (P.ph_hi > 4096) cg::this_grid().sync();
            xcd_barrier(xb); }
    }
}

extern "C" void kernel_launch(void* const* d_in, const int* in_sizes, int n_in, void* d_out, int out_size, void* d_ws, size_t ws_size, hipStream_t stream) {
    static int grid = 0;
    if (grid == 0) {
        if (n_in != 21 || ws_size < WS_END) { fprintf(stderr, "kernel_launch: need 21 inputs and %zu bytes of workspace, got %d / %zu\n", (size_t)WS_END, n_in, ws_size); grid = -1; return; }
        int dev = 0, cus = 0, per_cu = 0;
        (void)hipGetDevice(&dev); (void)hipDeviceGetAttribute(&cus, hipDeviceAttributeMultiprocessorCount, dev);
        if (hipFuncSetAttribute((const void*)mega_fwd, hipFuncAttributeMaxDynamicSharedMemorySize, LDS_ALLOC) != hipSuccess) { fprintf(stderr, "kernel_launch: hipFuncSetAttribute failed\n"); grid = -1; return; }
        if (hipOccupancyMaxActiveBlocksPerMultiprocessor(&per_cu, (const void*)mega_fwd, NTHR, LDS_ALLOC) != hipSuccess || per_cu < 1) { fprintf(stderr, "kernel_launch: occupancy query gives %d\n", per_cu); per_cu = 1; }
        (void)hipGetLastError();
        grid = cus;
        if (grid != 256) { fprintf(stderr, "kernel_launch: built for 256 CUs (fused residual+norm epilogues need one unit per workgroup), got %d\n", grid); grid = -1; return; }
    }
    if (grid < 0) return;
    if (hipMemsetAsync((char*)d_ws + O_BAR, 0, 32768, stream) != hipSuccess) { fprintf(stderr, "kernel_launch: memset failed\n"); return; }
    Params p{};
    const float** pp = (const float**)&p;
    for (int i = 0; i < 21; ++i) pp[i] = (const float*)d_in[i];
    p.out = (float*)d_out; p.ws = (unsigned char*)d_ws;
#if N_LAUNCH_MODE == 1
    p.ph_lo = 0; p.ph_hi = NPHASE;
    void* args[] = {&p};
    hipError_t e = hipLaunchCooperativeKernel((const void*)mega_fwd, dim3(grid), dim3(NTHR), args, LDS_ALLOC, stream);
    if (e != hipSuccess) fprintf(stderr, "cooperative launch failed: %s (grid %d)\n", hipGetErrorString(e), grid);
#else
    for (int ph = 0; ph < NPHASE; ++ph) { p.ph_lo = ph; p.ph_hi = ph + 1; hipLaunchKernelGGL(mega_fwd, dim3(grid), dim3(NTHR), LDS_ALLOC, stream, p); }
#endif
}
```
